# Optimizing an MI355X kernel written in HIP

```python
import math
import jax, jax.numpy as jnp
from jax import lax
import numpy as np


D_MODEL = 2048
BATCH = 4
SEQ = 2048
DEPTH = 1
DEC_BATCH = 16
DEC_SEQ = 64
PAST_LEN = 2048

CHUNK = 64
N_META = 16
MIX_WIDTH = D_MODEL
POOL_WIDTH = MIX_WIDTH // 2
POOL_WINDOWS = (2, 4, 8, 16)
POOL_GROUPS = len(POOL_WINDOWS)
POOL_GROUP_DIM = POOL_WIDTH // POOL_GROUPS
POOL_STATE = max(POOL_WINDOWS) - 1
ATTN_WIDTH = MIX_WIDTH - POOL_WIDTH
DIFF_HEADS = 8
V_DIM = ATTN_WIDTH // DIFF_HEADS
HALF_DIM = V_DIM // 2
QK_DIM = 2 * HALF_DIM
QK_WIDTH = DIFF_HEADS * QK_DIM
IN_WIDTH = POOL_WIDTH + 2 * QK_WIDTH + ATTN_WIDTH
ATT_SCALE = HALF_DIM ** -0.5
D_FF = -(-8 * D_MODEL // (3 * 256)) * 256
NUM_BUCKETS = 32
MAX_DISTANCE = 128
QB = 128
EPS = 1e-6
SUBLN_EPS = 1e-5
NEG_INF = -1e30

kernel_name = "hymba_pool_diffattn_stream_step"


def _rmsnorm(x, g, eps=EPS):
    xf = x.astype(jnp.float32)
    y = xf * lax.rsqrt(jnp.mean(xf * xf, axis=-1, keepdims=True) + eps)
    return (y * g.astype(jnp.float32)).astype(x.dtype)


def _chunk_id(idx):
    return jnp.where(idx < N_META, -1, (idx - N_META) // CHUNK)


def _t5_bucket(rel):
    half = NUM_BUCKETS // 2
    max_exact = half // 2
    ret = jnp.where(rel > 0, half, 0)
    n = jnp.abs(rel)
    nf = jnp.maximum(n, 1).astype(jnp.float32)
    large = max_exact + (jnp.log(nf / max_exact) / math.log(MAX_DISTANCE / max_exact)
                         * (half - max_exact)).astype(jnp.int32)
    large = jnp.minimum(large, half - 1)
    return ret + jnp.where(n < max_exact, n, large)


def _rel_bias(rel, table):
    return jnp.transpose(table[_t5_bucket(rel)], (2, 0, 1))


def _project(h, g_mix, w_in):
    b, t, _ = h.shape
    proj = _rmsnorm(h, g_mix) @ w_in
    u = proj[..., :POOL_WIDTH]
    q = proj[..., POOL_WIDTH:POOL_WIDTH + QK_WIDTH].reshape(b, t, DIFF_HEADS, 2, HALF_DIM)
    k = proj[..., POOL_WIDTH + QK_WIDTH:POOL_WIDTH + 2 * QK_WIDTH].reshape(b, t, DIFF_HEADS, QK_DIM)
    v = proj[..., POOL_WIDTH + 2 * QK_WIDTH:].reshape(b, t, DIFF_HEADS, V_DIM)
    return u, q, k, v


def _pool_mixer(u, w_pool, pool_scale):
    b, L, _ = u.shape
    uf = u.astype(jnp.float32)
    cs = jnp.concatenate([jnp.zeros((b, 1, POOL_WIDTH), jnp.float32), jnp.cumsum(uf, axis=1)], axis=1)
    idx = jnp.arange(L)
    means = []
    for g, w in enumerate(POOL_WINDOWS):
        csg = cs[..., g * POOL_GROUP_DIM:(g + 1) * POOL_GROUP_DIM]
        lo = jnp.maximum(idx + 1 - w, 0)
        cnt = (idx + 1 - lo).astype(jnp.float32)
        means.append((csg[:, 1:] - csg[:, lo]) / cnt[None, :, None])
    p = (jnp.concatenate(means, axis=-1) - uf).astype(u.dtype)
    p = p.reshape(b, L, POOL_GROUPS, POOL_GROUP_DIM)
    y = jnp.einsum('blgc,gcd->blgd', p, w_pool).reshape(b, L, POOL_WIDTH)
    return y * pool_scale


def _diff_attention(q, k, v, bias, mask, lam, g_subln, lambda_init):
    b, tq = q.shape[:2]
    lk = k.shape[1]
    k2 = k.reshape(b, lk, DIFF_HEADS, 2, HALF_DIM)
    logits = (jnp.einsum('bqhmd,bkhmd->bhmqk', q, k2).astype(jnp.float32) * ATT_SCALE
              + bias[None, :, None].astype(jnp.float32))
    logits = jnp.where(mask, logits, NEG_INF)
    a = jax.nn.softmax(logits, axis=-1)
    wts = a[:, :, 0] - lam * a[:, :, 1]
    o = jnp.einsum('bhqk,bkhe->bqhe', wts.astype(v.dtype), v)
    o = _rmsnorm(o, g_subln, SUBLN_EPS) * (1.0 - lambda_init)
    return o.reshape(b, tq, ATTN_WIDTH)


def _prompt_attention(q, k, v, rel_table, lam, g_subln, lambda_init):
    b, L = q.shape[:2]
    nb = -(-L // QB)
    Lp = nb * QB
    q_pad = jnp.pad(q, ((0, 0), (0, Lp - L), (0, 0), (0, 0), (0, 0)))
    kidx = jnp.arange(L)
    kchunk = _chunk_id(kidx)

    def block(bi):
        qb = lax.dynamic_slice_in_dim(q_pad, bi * QB, QB, axis=1)
        qidx = bi * QB + jnp.arange(QB)
        mask = kchunk[None, :] <= _chunk_id(qidx)[:, None]
        bias = _rel_bias(kidx[None, :] - qidx[:, None], rel_table)
        return _diff_attention(qb, k, v, bias, mask, lam, g_subln, lambda_init)

    out = lax.map(block, jnp.arange(nb))
    return jnp.transpose(out, (1, 0, 2, 3)).reshape(b, Lp, ATTN_WIDTH)[:, :L]


def _swiglu(h, g_ffn, w_gate, w_up, w_down):
    n = _rmsnorm(h, g_ffn)
    return h + (jax.nn.silu(n @ w_gate) * (n @ w_up)) @ w_down


def setup_inputs(seed: int = 0) -> dict:
    key = jax.random.key(seed)
    ks = jax.random.split(key, 24)
    f32 = jnp.float32
    nrm = lambda k, s, sc: jax.random.normal(k, s, f32) * sc
    gain = lambda k, s: 1.0 + 0.1 * jax.random.normal(k, s, f32)
    return {
        "x_prompt": nrm(ks[0], (BATCH, SEQ, D_MODEL), 1.0),
        "x_sample": nrm(ks[1], (DEC_BATCH, DEC_SEQ, D_MODEL), 1.0),
        "cache_k": nrm(ks[2], (DEPTH, DEC_BATCH, N_META + PAST_LEN, DIFF_HEADS, QK_DIM), 1.0),
        "cache_v": nrm(ks[3], (DEPTH, DEC_BATCH, N_META + PAST_LEN, DIFF_HEADS, V_DIM), 1.0),
        "state_pool": nrm(ks[4], (DEPTH, DEC_BATCH, POOL_STATE, POOL_WIDTH), 1.0),
        "meta": nrm(ks[5], (N_META, D_MODEL), 1.0),
        "g_mix": gain(ks[6], (DEPTH, D_MODEL)),
        "w_in": nrm(ks[7], (DEPTH, D_MODEL, IN_WIDTH), D_MODEL ** -0.5),
        "w_pool": nrm(ks[8], (DEPTH, POOL_GROUPS, POOL_GROUP_DIM, POOL_GROUP_DIM), POOL_GROUP_DIM ** -0.5),
        "pool_scale": gain(ks[9], (DEPTH, POOL_WIDTH)),
        "lambda_q1": nrm(ks[10], (DEPTH, HALF_DIM), 0.1),
        "lambda_k1": nrm(ks[11], (DEPTH, HALF_DIM), 0.1),
        "lambda_q2": nrm(ks[12], (DEPTH, HALF_DIM), 0.1),
        "lambda_k2": nrm(ks[13], (DEPTH, HALF_DIM), 0.1),
        "g_subln": gain(ks[14], (DEPTH, V_DIM)),
        "w_out": nrm(ks[15], (DEPTH, MIX_WIDTH, D_MODEL), MIX_WIDTH ** -0.5),
        "g_ffn": gain(ks[16], (DEPTH, D_MODEL)),
        "w_gate": nrm(ks[17], (DEPTH, D_MODEL, D_FF), D_MODEL ** -0.5),
        "w_up": nrm(ks[18], (DEPTH, D_MODEL, D_FF), D_MODEL ** -0.5),
        "w_down": nrm(ks[19], (DEPTH, D_FF, D_MODEL), D_FF ** -0.5),
        "rel_bias": nrm(ks[20], (NUM_BUCKETS, DIFF_HEADS), 0.5),
        "g_final": gain(ks[21], (D_MODEL,)),
    }


def reference(x_prompt, x_sample, cache_k, cache_v, state_pool, meta, g_mix, w_in, w_pool,
              pool_scale, lambda_q1, lambda_k1, lambda_q2, lambda_k2, g_subln, w_out, g_ffn,
              w_gate, w_up, w_down, rel_bias, g_final):
    f32 = jnp.float32
    b = x_prompt.shape[0]
    h_p = jnp.concatenate(
        [jnp.broadcast_to(meta[None].astype(x_prompt.dtype), (b, N_META, D_MODEL)), x_prompt], axis=1)
    h_s = x_sample
    kp_l, vp_l, pp_l, ks_l, vs_l, ps_l = [], [], [], [], [], []
    for l in range(DEPTH):
        lambda_init = 0.8 - 0.6 * math.exp(-0.3 * l)
        lam = (jnp.exp(jnp.sum(lambda_q1[l].astype(f32) * lambda_k1[l].astype(f32)))
               - jnp.exp(jnp.sum(lambda_q2[l].astype(f32) * lambda_k2[l].astype(f32)))
               + lambda_init)

        u_p, q_p, k_p, v_p = _project(h_p, g_mix[l], w_in[l])
        a_p = _pool_mixer(u_p, w_pool[l], pool_scale[l])
        b_p = _prompt_attention(q_p, k_p, v_p, rel_bias, lam, g_subln[l], lambda_init)
        h_p = h_p + jnp.concatenate([a_p, b_p], axis=-1) @ w_out[l]
        h_p = _swiglu(h_p, g_ffn[l], w_gate[l], w_up[l], w_down[l])

        u_s, q_s, k_s, v_s = _project(h_s, g_mix[l], w_in[l])
        t = h_s.shape[1]
        ctx = jnp.concatenate([state_pool[l].astype(u_s.dtype), u_s], axis=1)
        a_s = _pool_mixer(ctx, w_pool[l], pool_scale[l])[:, POOL_STATE:]
        k_all = jnp.concatenate([cache_k[l].astype(k_s.dtype), k_s], axis=1)
        v_all = jnp.concatenate([cache_v[l].astype(v_s.dtype), v_s], axis=1)
        lk = k_all.shape[1]
        kidx = jnp.arange(lk)
        qidx = lk - t + jnp.arange(t)
        mask = _chunk_id(kidx)[None, :] <= _chunk_id(qidx)[:, None]
        bias = _rel_bias(kidx[None, :] - qidx[:, None], rel_bias)
        b_s = _diff_attention(q_s, k_all, v_all, bias, mask, lam, g_subln[l], lambda_init)
        h_s = h_s + jnp.concatenate([a_s, b_s], axis=-1) @ w_out[l]
        h_s = _swiglu(h_s, g_ffn[l], w_gate[l], w_up[l], w_down[l])

        kp_l.append(k_p)
        vp_l.append(v_p)
        pp_l.append(u_p[:, -POOL_STATE:])
        ks_l.append(k_s)
        vs_l.append(v_s)
        ps_l.append(ctx[:, -POOL_STATE:])

    y_prompt = _rmsnorm(h_p[:, N_META:], g_final)
    y_sample = _rmsnorm(h_s, g_final)
    k_prompt = jnp.stack(kp_l, axis=0)
    v_prompt = jnp.stack(vp_l, axis=0)
    pool_prompt = jnp.stack(pp_l, axis=0)
    k_sample = jnp.stack(ks_l, axis=0)
    v_sample = jnp.stack(vs_l, axis=0)
    pool_sample = jnp.stack(ps_l, axis=0)
    return (y_prompt, y_sample, k_prompt, v_prompt, pool_prompt, k_sample, v_sample, pool_sample)
```

```cpp
#include <hip/hip_runtime.h>
#include <hip/hip_cooperative_groups.h>
#include <cstdio>
#include <cstdint>
namespace cg = cooperative_groups;

constexpr int DM = 2048, NB = 4, SEQ = 2048, DB = 16, DSEQ = 64, PAST = 2048, NMETA = 16;
constexpr int LP = NMETA + SEQ;
constexpr int LC = NMETA + PAST;
constexpr int LS = LC + DSEQ;
constexpr int PW = 1024, QKW = 1024, AW = 1024, INW = 4096, DFF = 5632, NH = 8;
constexpr int MROWS = NB * SEQ + DB * DSEQ;
constexpr int MPAD = 9472;
constexpr int ROW_S0 = NB * SEQ;
constexpr int ROW_M0 = MROWS;
constexpr float EPS = 1e-6f, SUBLN_EPS = 1e-5f;
constexpr float LOG2E = 1.4426950408889634f;
constexpr float QSCALE = 0.125f * LOG2E;

constexpr size_t O_Y = 0;
constexpr size_t O_KP = (size_t)MROWS * DM;
constexpr size_t O_VP = O_KP + (size_t)NB * LP * 1024;
constexpr size_t O_PP = O_VP + (size_t)NB * LP * 1024;
constexpr size_t O_KS = O_PP + (size_t)NB * 15 * 1024;
constexpr size_t O_VS = O_KS + (size_t)DB * DSEQ * 1024;
constexpr size_t O_PS = O_VS + (size_t)DB * DSEQ * 1024;
constexpr size_t O_END = O_PS + (size_t)DB * 15 * 1024;

constexpr size_t MiB = 1u << 20;
constexpr size_t WS_CTL = 0, CTL_BYTES = 1 * MiB;
constexpr size_t WS_WINT = 1 * MiB, WS_WOUTT = 17 * MiB, WS_WGUT = 25 * MiB, WS_WDT = 69 * MiB, WS_WPT = 91 * MiB;
constexpr size_t WS_XN = 92 * MiB;
constexpr size_t WS_Q = 129 * MiB;
constexpr size_t WS_KP = 148 * MiB, WS_VP = 165 * MiB;
constexpr size_t WS_UP = 182 * MiB;
constexpr size_t WS_US = 199 * MiB;
constexpr size_t WS_P = 202 * MiB;
constexpr size_t WS_MIX = 220 * MiB;
constexpr size_t WS_H1 = 256 * MiB;
constexpr size_t WS_KS = 328 * MiB, WS_VS = 395 * MiB;
constexpr size_t WS_HMID = 328 * MiB;
constexpr size_t WS_END = 462 * MiB;
constexpr int CW_SS1 = 16384, CW_SS2 = 32768;

typedef unsigned short bf16_t;
typedef short bf16x8 __attribute__((ext_vector_type(8)));
typedef short s16x4 __attribute__((ext_vector_type(4)));
typedef float f32x4 __attribute__((ext_vector_type(4)));
typedef float f32x2 __attribute__((ext_vector_type(2)));
typedef float f32x16 __attribute__((ext_vector_type(16)));
typedef unsigned u32x4 __attribute__((ext_vector_type(4)));
typedef unsigned u32x2 __attribute__((ext_vector_type(2)));
#define LAS __attribute__((address_space(3)))

__device__ __forceinline__ unsigned cvt_pk_bf16(float lo, float hi) { unsigned r; asm volatile("v_cvt_pk_bf16_f32 %0, %1, %2" : "=v"(r) : "v"(lo), "v"(hi)); return r; }
__device__ __forceinline__ float bf2f(unsigned short h) { return __uint_as_float((unsigned)h << 16); }
__device__ __forceinline__ float wave_sum(float v) {
#pragma unroll
    for (int o = 1; o < 64; o <<= 1) v += __shfl_xor(v, o);
    return v;
}

namespace pg8 {
constexpr int BM = 256, BK = 64, HALF = 128, HTB = HALF * BK * 2, STAGE_BYTES = 8 * HTB, NXCD = 8, WGM = 8;
__host__ __device__ __forceinline__ int lds_byte(int r, int c) { const int st = (r >> 4) * 2 + (c >> 5), rr = r & 15, cc = c & 31, ob = rr * 64 + cc * 2; return st * 1024 + (ob ^ (((ob >> 9) & 1) << 5)); }
__host__ __device__ __forceinline__ void stage_rc(int b, int& R, int& C) { const int st = b / 1024, sb = b % 1024, swz = sb ^ (((sb >> 9) & 1) << 5); R = (st >> 1) * 16 + swz / 64; C = (st & 1) * 32 + (swz % 64) / 2; }
__host__ __device__ __forceinline__ int perm32(int rho) { const int n = rho >> 4, i = rho & 15; return 8 * (i >> 2) + 4 * n + (i & 3); }

struct Unit { int pm, pn; };
struct Gemm { const bf16_t* A; const bf16_t* Bt; int lda, ldb, K, a_pn_off; };

struct StaticOrder {
    int nM, nN, nwg, G, c;
    __device__ void init(int nM_, int nN_, int G_, int c_) { nM = nM_; nN = nN_; nwg = nM * nN; G = G_; c = c_; }
    __device__ bool next(int i, Unit& u) const {
        const long L = (long)i * G + c; if (L >= nwg) return false;
        int wgid = (int)L; { const int q = nwg / NXCD, r = nwg % NXCD, xcd = wgid % NXCD, off = wgid / NXCD; wgid = (xcd < r ? xcd * (q + 1) : r * (q + 1) + (xcd - r) * q) + off; }
        const int nig = WGM * nN, gid = wgid / nig, fm = gid * WGM, gsz = (nM - fm) < WGM ? (nM - fm) : WGM;
        u.pm = fm + ((wgid % nig) % gsz); u.pn = (wgid % nig) / gsz; return true;
    }
};

template <class Epi>
__device__ __forceinline__ void gemm_phase(LAS unsigned char* lds, const int tid, const Gemm g, const StaticOrder& S, const Epi& E) {
    const int wid = __builtin_amdgcn_readfirstlane(tid >> 6), lane = tid & 63, wr = wid >> 2, wc = wid & 3, fr = lane & 15, fq = lane >> 4;
    const int K = g.K, nt = K / BK;
    unsigned voffA[2], voffB[2];
#pragma unroll
    for (int i = 0; i < 2; ++i) { int R, C; stage_rc(tid * 16 + i * 8192, R, C); const int Rb = Epi::PERM ? ((R & ~31) + perm32(R & 31)) : R;
        voffA[i] = (unsigned)(R * g.lda + C) * 2u; voffB[i] = (unsigned)(Rb * g.ldb + C) * 2u; }
    const size_t kstep = (size_t)(BK * 2);
    const size_t hstepA = (size_t)HALF * g.lda * 2, hstepB = (size_t)HALF * g.ldb * 2;
    const size_t tstepA = 2 * hstepA, tstepB = 2 * hstepB;
    const unsigned ldsw = (unsigned)wid * 1024u;
    const int aoff = lds_byte(wr * 64 + fr, fq * 8), boff = lds_byte(wc * 32 + fr, fq * 8);
#define PG8_SA(b, h) (((b) * 2 + (h)) * HTB)
#define PG8_SB(b, h) ((4 + (b) * 2 + (h)) * HTB)
#define PG8_STAGE(bufoff, gbase, voff) do { _Pragma("unroll") for (int _i = 0; _i < 2; ++_i) \
        __builtin_amdgcn_global_load_lds((const unsigned*)((const char*)(gbase) + (voff)[_i]), (LAS unsigned*)(lds + (bufoff) + ldsw + _i * 8192), 16, 0, 0); } while (0)
#define PG8_LDA(dst, b, h) do { _Pragma("unroll") for (int m = 0; m < 4; ++m) _Pragma("unroll") for (int k = 0; k < 2; ++k) dst[m][k] = *(const LAS bf16x8*)(lds + PG8_SA(b, h) + aoff + m * 2048 + k * 1024); } while (0)
#define PG8_LDB(dst, b, h) do { _Pragma("unroll") for (int n = 0; n < 2; ++n) _Pragma("unroll") for (int k = 0; k < 2; ++k) dst[n][k] = *(const LAS bf16x8*)(lds + PG8_SB(b, h) + boff + n * 2048 + k * 1024); } while (0)
#define PG8_MMA(ai, bj, At, Bt) do { __builtin_amdgcn_s_setprio(1); _Pragma("unroll") for (int m = 0; m < 4; ++m) _Pragma("unroll") for (int n = 0; n < 2; ++n) _Pragma("unroll") for (int k = 0; k < 2; ++k) \
        acc[ai][bj][m][n] = __builtin_amdgcn_mfma_f32_16x16x32_bf16(Bt[n][k], At[m][k], acc[ai][bj][m][n], 0, 0, 0); __builtin_amdgcn_s_setprio(0); } while (0)
#define PG8_WAIT_V(n) asm volatile("s_waitcnt vmcnt(" #n ")" ::: "memory")
#define PG8_WAIT_L(n) asm volatile("s_waitcnt lgkmcnt(" #n ")" ::: "memory")
#define PG8_BAR __builtin_amdgcn_s_barrier()
#define PG8_SCHED __builtin_amdgcn_sched_barrier(0)
    Unit cur, nxt; int ui = 0;
    if (!S.next(0, cur)) return;
    f32x4 acc[2][2][4][2];
#pragma unroll
    for (int a = 0; a < 2; ++a)
#pragma unroll
        for (int b = 0; b < 2; ++b)
#pragma unroll
            for (int m = 0; m < 4; ++m)
#pragma unroll
                for (int n = 0; n < 2; ++n) acc[a][b][m][n] = (f32x4){0.f, 0.f, 0.f, 0.f};
    bf16x8 At[4][2], B0[2][2], B1[2][2];
    const char* cA = (const char*)g.A + (size_t)cur.pm * tstepA + (size_t)cur.pn * g.a_pn_off * 2; const char* cB = (const char*)g.Bt + (size_t)cur.pn * tstepB;
    PG8_STAGE(PG8_SB(0, 0), cB, voffB); PG8_STAGE(PG8_SB(0, 1), cB + hstepB, voffB); PG8_STAGE(PG8_SA(0, 0), cA, voffA); PG8_STAGE(PG8_SA(0, 1), cA + hstepA, voffA);
    if (wr == 1) PG8_BAR;
    PG8_WAIT_V(2); PG8_BAR;
    PG8_STAGE(PG8_SB(1, 0), cB + kstep, voffB); PG8_STAGE(PG8_SA(1, 0), cA + kstep, voffA); PG8_STAGE(PG8_SB(1, 1), cB + hstepB + kstep, voffB);
    PG8_WAIT_V(6); PG8_BAR;
    for (;;) {
        const bool has_next = S.next(ui + 1, nxt);
        const char* nA = has_next ? (const char*)g.A + (size_t)nxt.pm * tstepA + (size_t)nxt.pn * g.a_pn_off * 2 : cA; const char* nB = has_next ? (const char*)g.Bt + (size_t)nxt.pn * tstepB : cB;
        for (int t = 0; t < nt; t += 2) {
            const bool last = (t == nt - 2);
            const char* a1 = cA + (size_t)(t + 1) * kstep;
            const char* a2 = last ? nA : cA + (size_t)(t + 2) * kstep; const char* b2 = last ? nB : cB + (size_t)(t + 2) * kstep;
            const char* a3 = a2 + kstep; const char* b3 = b2 + kstep;
            PG8_LDB(B0, 0, 0); PG8_LDB(B1, 0, 1); PG8_SCHED; PG8_LDA(At, 0, 0); PG8_STAGE(PG8_SA(1, 1), a1 + hstepA, voffA);
            PG8_WAIT_V(8); PG8_WAIT_L(0); PG8_BAR; PG8_MMA(0, 0, At, B0); PG8_MMA(0, 1, At, B1); PG8_BAR; PG8_SCHED;
            PG8_LDA(At, 0, 1); PG8_STAGE(PG8_SB(0, 0), b2, voffB); PG8_STAGE(PG8_SB(0, 1), b2 + hstepB, voffB); PG8_STAGE(PG8_SA(0, 0), a2, voffA);
            PG8_WAIT_V(8); PG8_WAIT_L(0); PG8_BAR; PG8_MMA(1, 0, At, B0); PG8_MMA(1, 1, At, B1); PG8_BAR; PG8_SCHED;
            PG8_LDB(B0, 1, 0); PG8_LDB(B1, 1, 1); PG8_SCHED; PG8_LDA(At, 1, 0); PG8_STAGE(PG8_SA(0, 1), a2 + hstepA, voffA);
            PG8_WAIT_V(8); PG8_WAIT_L(0); PG8_BAR; PG8_MMA(0, 0, At, B0); PG8_MMA(0, 1, At, B1); PG8_BAR; PG8_SCHED;
            PG8_LDA(At, 1, 1); PG8_STAGE(PG8_SB(1, 0), b3, voffB); PG8_STAGE(PG8_SB(1, 1), b3 + hstepB, voffB); PG8_STAGE(PG8_SA(1, 0), a3, voffA);
            PG8_WAIT_V(8); PG8_WAIT_L(0); PG8_BAR; PG8_MMA(1, 0, At, B0); PG8_MMA(1, 1, At, B1); PG8_BAR; PG8_SCHED;
        }
        if (wr == 0) PG8_BAR;
        E(acc, cur, wr, wc, fr, fq);
        if (!has_next) break;
#pragma unroll
        for (int a = 0; a < 2; ++a)
#pragma unroll
            for (int b = 0; b < 2; ++b)
#pragma unroll
                for (int m = 0; m < 4; ++m)
#pragma unroll
                    for (int n = 0; n < 2; ++n) acc[a][b][m][n] = (f32x4){0.f, 0.f, 0.f, 0.f};
        cur = nxt; cA = nA; cB = nB; ++ui;
        if (wr == 1) PG8_BAR;
    }
    PG8_WAIT_V(0);
    PG8_BAR;
#undef PG8_SA
#undef PG8_SB
#undef PG8_STAGE
#undef PG8_LDA
#undef PG8_LDB
#undef PG8_MMA
#undef PG8_WAIT_V
#undef PG8_WAIT_L
#undef PG8_BAR
#undef PG8_SCHED
}
}

__device__ __forceinline__ u32x4 pack8(const f32x4 a, const f32x4 b) { u32x4 w; w.x = cvt_pk_bf16(a[0], a[1]); w.y = cvt_pk_bf16(a[2], a[3]); w.z = cvt_pk_bf16(b[0], b[1]); w.w = cvt_pk_bf16(b[2], b[3]); return w; }

struct EpiInProj {
    static constexpr bool PERM = true;
    bf16_t *Qb, *KP, *VP, *KS, *VS, *UP, *US; float* out;
    __device__ __forceinline__ void operator()(const f32x4 (&acc)[2][2][4][2], const pg8::Unit& u, int wr, int wc, int fr, int fq) const {
        const int region = u.pn >> 2, cb = (u.pn & 3) * 256 + wc * 32 + 8 * fq, cls = u.pm < 32 ? 0 : (u.pm < 36 ? 1 : 2);
        const int row0 = u.pm * 256 + wr * 64 + fr;
#pragma unroll
        for (int ai = 0; ai < 2; ++ai)
#pragma unroll
            for (int m = 0; m < 4; ++m) {
                const int r = row0 + ai * 128 + m * 16;
#pragma unroll
                for (int bj = 0; bj < 2; ++bj) {
                    const int c = cb + bj * 128; const f32x4 v0 = acc[ai][bj][m][0], v1 = acc[ai][bj][m][1];
                    if (region == 1) { *(u32x4*)(Qb + (size_t)r * 1024 + c) = pack8(v0 * QSCALE, v1 * QSCALE); }
                    else if (region == 0) {
                        const u32x4 w = pack8(v0, v1);
                        if (cls == 0) { const int b = r >> 11, i = r & 2047; *(u32x4*)(UP + ((size_t)b * LP + 16 + i) * 1024 + c) = w;
                            if (i >= SEQ - 15) { float* o = out + O_PP + ((size_t)b * 15 + (i - (SEQ - 15))) * 1024 + c; *(f32x4*)o = v0; *(f32x4*)(o + 4) = v1; } }
                        else if (cls == 1) { const int rs = r - ROW_S0, b = rs >> 6, t = rs & 63; *(u32x4*)(US + ((size_t)b * 79 + 15 + t) * 1024 + c) = w;
                            if (t >= DSEQ - 15) { float* o = out + O_PS + ((size_t)b * 15 + (t - (DSEQ - 15))) * 1024 + c; *(f32x4*)o = v0; *(f32x4*)(o + 4) = v1; } }
                        else { const int j = r - ROW_M0; if (j < NMETA) { for (int b = 0; b < NB; ++b) *(u32x4*)(UP + ((size_t)b * LP + j) * 1024 + c) = w; } }
                    } else {
                        const u32x4 w = pack8(v0, v1);
                        bf16_t* Pb = region == 2 ? KP : VP; bf16_t* Sb = region == 2 ? KS : VS;
                        float* oP = out + (region == 2 ? O_KP : O_VP); float* oS = out + (region == 2 ? O_KS : O_VS);
                        if (cls == 0) { const int b = r >> 11, i = r & 2047; const size_t e = ((size_t)b * LP + 16 + i) * 1024 + c; *(u32x4*)(Pb + e) = w; *(f32x4*)(oP + e) = v0; *(f32x4*)(oP + e + 4) = v1; }
                        else if (cls == 1) { const int rs = r - ROW_S0, b = rs >> 6, t = rs & 63; *(u32x4*)(Sb + ((size_t)b * LS + LC + t) * 1024 + c) = w;
                            const size_t e = (size_t)rs * 1024 + c; *(f32x4*)(oS + e) = v0; *(f32x4*)(oS + e + 4) = v1; }
                        else { const int j = r - ROW_M0; if (j < NMETA) { for (int b = 0; b < NB; ++b) { const size_t e = ((size_t)b * LP + j) * 1024 + c; *(u32x4*)(Pb + e) = w; *(f32x4*)(oP + e) = v0; *(f32x4*)(oP + e + 4) = v1; } } }
                    }
                }
            }
    }
};

struct EpiPool {
    static constexpr bool PERM = true;
    bf16_t* MIX; const float* scale;
    __device__ __forceinline__ void operator()(const f32x4 (&acc)[2][2][4][2], const pg8::Unit& u, int wr, int wc, int fr, int fq) const {
        const int c0 = u.pn * 256 + wc * 32 + 8 * fq, row0 = u.pm * 256 + wr * 64 + fr;
        f32x4 sc[2][2];
#pragma unroll
        for (int bj = 0; bj < 2; ++bj)
#pragma unroll
            for (int n = 0; n < 2; ++n) sc[bj][n] = *(const f32x4*)(scale + c0 + bj * 128 + 4 * n);
#pragma unroll
        for (int ai = 0; ai < 2; ++ai)
#pragma unroll
            for (int m = 0; m < 4; ++m) { const int r = row0 + ai * 128 + m * 16;
#pragma unroll
                for (int bj = 0; bj < 2; ++bj) *(u32x4*)(MIX + (size_t)r * 2048 + c0 + bj * 128) = pack8(acc[ai][bj][m][0] * sc[bj][0], acc[ai][bj][m][1] * sc[bj][1]); }
    }
};

struct EpiOutProj {
    static constexpr bool PERM = false;
    const float *xp, *xs, *gffn; float* H1; bf16_t* XN2; float* ss;
    __device__ __forceinline__ void operator()(const f32x4 (&acc)[2][2][4][2], const pg8::Unit& u, int wr, int wc, int fr, int fq) const {
        const int c0 = u.pn * 256 + wc * 32 + 4 * fq, row0 = u.pm * 256 + wr * 64 + fr;
        const float* xb = u.pm < 32 ? xp : xs - (size_t)ROW_S0 * DM;
        f32x4 gv[2][2];
#pragma unroll
        for (int bj = 0; bj < 2; ++bj)
#pragma unroll
            for (int n = 0; n < 2; ++n) gv[bj][n] = *(const f32x4*)(gffn + c0 + bj * 128 + 16 * n);
#pragma unroll
        for (int ai = 0; ai < 2; ++ai)
#pragma unroll
            for (int m = 0; m < 4; ++m) { const int r = row0 + ai * 128 + m * 16; const size_t off = (size_t)r * DM + c0; float s = 0.f;
#pragma unroll
                for (int bj = 0; bj < 2; ++bj)
#pragma unroll
                    for (int n = 0; n < 2; ++n) { const size_t o = off + bj * 128 + 16 * n; const f32x4 h = *(const f32x4*)(xb + o) + acc[ai][bj][m][n];
                        *(f32x4*)(H1 + o) = h; const f32x4 hg = h * gv[bj][n]; u32x2 w; w.x = cvt_pk_bf16(hg[0], hg[1]); w.y = cvt_pk_bf16(hg[2], hg[3]); *(u32x2*)(XN2 + o) = w;
                        s += (h[0] * h[0] + h[1] * h[1]) + (h[2] * h[2] + h[3] * h[3]); }
                s += __shfl_xor(s, 16); s += __shfl_xor(s, 32);
                if (fq == 0) atomicAdd(ss + r, s);
                if (m & 1) asm volatile("" ::: "memory"); }
    }
};

struct EpiFFN1 {
    static constexpr bool PERM = true;
    bf16_t* HM; const float* ss;
    __device__ __forceinline__ void operator()(const f32x4 (&acc)[2][2][4][2], const pg8::Unit& u, int wr, int wc, int fr, int fq) const {
        const int c0 = u.pn * 128 + wc * 32 + 8 * fq, row0 = u.pm * 256 + wr * 64 + fr;
#pragma unroll
        for (int ai = 0; ai < 2; ++ai)
#pragma unroll
            for (int m = 0; m < 4; ++m) { const int r = row0 + ai * 128 + m * 16; const float rstd = 1.0f / sqrtf(ss[r] * (1.0f / DM) + EPS);
                f32x4 o[2];
#pragma unroll
                for (int n = 0; n < 2; ++n)
#pragma unroll
                    for (int j = 0; j < 4; ++j) { const float gt = acc[ai][0][m][n][j] * rstd, up = acc[ai][1][m][n][j] * rstd;
                        o[n][j] = gt * __builtin_amdgcn_rcpf(1.0f + __builtin_amdgcn_exp2f(-gt * LOG2E)) * up; }
                *(u32x4*)(HM + (size_t)r * DFF + c0) = pack8(o[0], o[1]); }
    }
};

struct EpiDown {
    static constexpr bool PERM = false;
    const float* H1; float* Y; float* ss;
    __device__ __forceinline__ void operator()(const f32x4 (&acc)[2][2][4][2], const pg8::Unit& u, int wr, int wc, int fr, int fq) const {
        const int c0 = u.pn * 256 + wc * 32 + 4 * fq, row0 = u.pm * 256 + wr * 64 + fr;
#pragma unroll
        for (int ai = 0; ai < 2; ++ai)
#pragma unroll
            for (int m = 0; m < 4; ++m) { const int r = row0 + ai * 128 + m * 16; const size_t off = (size_t)r * DM + c0; float s = 0.f;
#pragma unroll
                for (int bj = 0; bj < 2; ++bj)
#pragma unroll
                    for (int n = 0; n < 2; ++n) { const size_t o = off + bj * 128 + 16 * n; const f32x4 h = *(const f32x4*)(H1 + o) + acc[ai][bj][m][n];
                        *(f32x4*)(Y + o) = h; s += (h[0] * h[0] + h[1] * h[1]) + (h[2] * h[2] + h[3] * h[3]); }
                s += __shfl_xor(s, 16); s += __shfl_xor(s, 32);
                if (fq == 0) atomicAdd(ss + r, s);
                if (m & 1) asm volatile("" ::: "memory"); }
    }
};

namespace att {
constexpr int SHM_V = 64 * 128 * 2, SHM_K = 64 * 128 * 2;
constexpr int OFF_V = 0, OFF_K = 2 * SHM_V, OFF_LUT = 2 * SHM_V + 2 * SHM_K, OFF_WS = OFF_LUT + 1024;
constexpr float NEG = -1e30f;
constexpr float THR2 = 8.0f * LOG2E;
#define KSWZ(row, colB) ((row) * 256 + ((colB) ^ (((row) & 7) << 4)))
#define SBAR() __builtin_amdgcn_sched_barrier(0)
__device__ __forceinline__ int crow(int r, int hi) { return (r & 3) + 8 * (r >> 2) + 4 * hi; }
__device__ __forceinline__ int v_st(int k, int c) { const int kk = (k & ~0xC) | ((k & 4) << 1) | ((k & 8) >> 1); return ((kk >> 3) * 4 + (c >> 5)) * 512 + ((kk & 7) * 32 + (c & 31)) * 2; }
__device__ __forceinline__ int v_rd_base(int lane) { return ((lane & 3) << 3) | (((lane >> 2) & 3) << 6) | (((lane >> 4) & 1) << 5) | (((lane >> 5) & 1) << 8); }
constexpr int v_rd_off(int d0, int ks, int half) { return d0 * 512 + ks * 4096 + half * 2048; }
template <int OFF> __device__ __forceinline__ s16x4 tr_read(int vb) {
    s16x4 r; asm volatile("ds_read_b64_tr_b16 %0, %1 offset:%2" : "=&v"(r) : "v"(vb), "i"(OFF) : "memory"); return r;
}
template <int D0> __device__ __forceinline__ void pv_one(f32x16& od, int vb, bf16x8 pa0, bf16x8 pa1, bf16x8 pa2, bf16x8 pa3) {
    const s16x4 l0 = tr_read<v_rd_off(D0, 0, 0)>(vb), h0 = tr_read<v_rd_off(D0, 0, 1)>(vb), l1 = tr_read<v_rd_off(D0, 1, 0)>(vb), h1 = tr_read<v_rd_off(D0, 1, 1)>(vb);
    const s16x4 l2 = tr_read<v_rd_off(D0, 2, 0)>(vb), h2 = tr_read<v_rd_off(D0, 2, 1)>(vb), l3 = tr_read<v_rd_off(D0, 3, 0)>(vb), h3 = tr_read<v_rd_off(D0, 3, 1)>(vb);
    asm volatile("s_waitcnt lgkmcnt(0)" ::: "memory"); SBAR();
#define PK(L, H) (bf16x8){L[0], L[1], L[2], L[3], H[0], H[1], H[2], H[3]}
    od = __builtin_amdgcn_mfma_f32_32x32x16_bf16(pa0, PK(l0, h0), od, 0, 0, 0);
    od = __builtin_amdgcn_mfma_f32_32x32x16_bf16(pa1, PK(l1, h1), od, 0, 0, 0);
    od = __builtin_amdgcn_mfma_f32_32x32x16_bf16(pa2, PK(l2, h2), od, 0, 0, 0);
    od = __builtin_amdgcn_mfma_f32_32x32x16_bf16(pa3, PK(l3, h3), od, 0, 0, 0);
#undef PK
}

struct Tensors { const bf16_t *Q, *KP, *VP, *KS, *VS; bf16_t* MIX; const float *rel_bias, *g_subln; float lam; };

template <int TYPE>
__device__ __forceinline__ void attn_unit(char* lds, int tid, const Tensors& T, int b, int h, int qb) {
    asm volatile("" : "+v"(tid));
    const int lane = tid & 63, r32 = lane & 31, hi = lane >> 5;
    const int wid = __builtin_amdgcn_readfirstlane(tid >> 6);
    const int rg = TYPE == 0 ? (wid & 3) : (wid & 1), mp = TYPE == 0 ? (wid >> 2) : ((wid >> 1) & 1), cs = TYPE == 0 ? 0 : (wid >> 2);
    constexpr int ND0 = TYPE == 0 ? 4 : 2;
    const long qrow0 = TYPE == 0 ? (long)b * SEQ + qb * 128 : (long)ROW_S0 + b * DSEQ;
    const bf16_t* Kh = TYPE == 0 ? T.KP + (size_t)b * LP * 1024 + h * 128 : T.KS + (size_t)b * LS * 1024 + h * 128;
    const bf16_t* Vh = TYPE == 0 ? T.VP + (size_t)b * LP * 1024 + h * 128 : T.VS + (size_t)b * LS * 1024 + h * 128;
    const int NT = TYPE == 0 ? 2 * qb + 3 : 34;
    const int qpos0 = TYPE == 0 ? qb * 128 : PAST;
    const int tmax = TYPE == 0 ? 2 * qb + (rg >> 1) + 1 : NT - 1;
    char* V_lds = lds + OFF_V; char* K_lds = lds + OFF_K; float* lut = (float*)(lds + OFF_LUT); float* wsf = (float*)(lds + OFF_WS) + wid * 64;
    if (tid < 256) { const int rel = tid - 128, n = rel < 0 ? -rel : rel;
        int bk = n < 8 ? n : n < 12 ? 8 : n < 16 ? 9 : n < 23 ? 10 : n < 32 ? 11 : n < 46 ? 12 : n < 64 ? 13 : n < 91 ? 14 : 15; if (rel > 0) bk += 16;
        lut[tid] = T.rel_bias[bk * NH + h] * LOG2E; }
    bf16x8 qr[4];
    { const bf16_t* Qw = T.Q + (size_t)(qrow0 + rg * 32 + r32) * 1024 + h * 128 + mp * 64 + hi * 8;
#pragma unroll
      for (int d0 = 0; d0 < 4; ++d0) qr[d0] = *(const bf16x8*)(Qw + d0 * 16); }
    const int qpos = qpos0 + rg * 32 + r32;
    const int sr = tid >> 4, sc = (tid & 15) * 8, vst0 = v_st(sr, sc), vst1 = v_st(32 + sr, sc);
    const int vb0 = (int)(uintptr_t)V_lds + v_rd_base(lane);
    bf16x8 vs0, vs1, ks0, ks1;
#define KROW0(t) ((t) == 0 ? 0 : 16 + 64 * ((t) - 1))
#define SLOAD(t) do { const long k0_ = KROW0(t); vs0 = *(const bf16x8*)(Vh + (k0_ + sr) * 1024 + sc); vs1 = *(const bf16x8*)(Vh + (k0_ + 32 + sr) * 1024 + sc); \
        ks0 = *(const bf16x8*)(Kh + (k0_ + sr) * 1024 + sc); ks1 = *(const bf16x8*)(Kh + (k0_ + 32 + sr) * 1024 + sc); } while (0)
#define SWRITE(bf) do { *(bf16x8*)(V_lds + (bf) * SHM_V + vst0) = vs0; *(bf16x8*)(V_lds + (bf) * SHM_V + vst1) = vs1; \
        *(bf16x8*)(K_lds + (bf) * SHM_K + KSWZ(sr, sc * 2)) = ks0; *(bf16x8*)(K_lds + (bf) * SHM_K + KSWZ(32 + sr, sc * 2)) = ks1; } while (0)
    float m_reg = NEG, l_reg = 0.f; f32x16 o[ND0];
#pragma unroll
    for (int d = 0; d < ND0; ++d) o[d] = f32x16{};
    SLOAD(0); SWRITE(0); SLOAD(1);
    __syncthreads();
    for (int t = 0; t < NT; ++t) {
        const int buf = t & 1;
        if (t + 1 < NT) { SWRITE(buf ^ 1); if (t + 2 < NT) SLOAD(t + 2); }
        if (t <= tmax) {
            const int kpos0 = t == 0 ? -NMETA : 64 * (t - 1);
            f32x16 p0, p1;
            const bool far = (t != 0) && (kpos0 + 63 - (qpos0 + rg * 32) <= -128);
            if (far) { const float cbv = lut[0];
#pragma unroll
                for (int r = 0; r < 16; ++r) { p0[r] = cbv; p1[r] = cbv; } }
            else {
#pragma unroll
                for (int r = 0; r < 16; ++r) { const int kk = crow(r, hi); int i0 = kpos0 + kk - qpos + 128; const int i1 = min(max(i0 + 32, 0), 255); i0 = min(max(i0, 0), 255);
                    p0[r] = lut[i0]; p1[r] = lut[i1];
                    if (t == 0) { p0[r] = kk < NMETA ? p0[r] : NEG; p1[r] = NEG; } }
            }
            const char* Kb = K_lds + buf * SHM_K;
#pragma unroll
            for (int d0 = 0; d0 < 4; ++d0) { const int cbyte = (mp * 64 + d0 * 16 + hi * 8) * 2;
                const bf16x8 b0 = *(const bf16x8*)(Kb + KSWZ(r32, cbyte));
                p0 = __builtin_amdgcn_mfma_f32_32x32x16_bf16(b0, qr[d0], p0, 0, 0, 0);
                if (t != 0) { const bf16x8 b1 = *(const bf16x8*)(Kb + KSWZ(32 + r32, cbyte)); p1 = __builtin_amdgcn_mfma_f32_32x32x16_bf16(b1, qr[d0], p1, 0, 0, 0); } }
            float pmax = p0[0];
#pragma unroll
            for (int r = 1; r < 16; ++r) pmax = fmaxf(pmax, p0[r]);
#pragma unroll
            for (int r = 0; r < 16; ++r) pmax = fmaxf(pmax, p1[r]);
            { auto rr = __builtin_amdgcn_permlane32_swap(__float_as_uint(pmax), __float_as_uint(pmax), false, false); pmax = fmaxf(__uint_as_float(rr[0]), __uint_as_float(rr[1])); }
            float alpha = 1.f;
            if (!__all(pmax - m_reg <= THR2)) { const float mn = fmaxf(m_reg, pmax); alpha = __builtin_amdgcn_exp2f(m_reg - mn); m_reg = mn; }
            float ps = 0.f;
#pragma unroll
            for (int r = 0; r < 16; ++r) { p0[r] = __builtin_amdgcn_exp2f(p0[r] - m_reg); p1[r] = __builtin_amdgcn_exp2f(p1[r] - m_reg); ps += p0[r] + p1[r]; }
            { auto rr = __builtin_amdgcn_permlane32_swap(__float_as_uint(ps), __float_as_uint(ps), false, false); ps = __uint_as_float(rr[0]) + __uint_as_float(rr[1]); }
            l_reg = l_reg * alpha + ps;
            if (__any(alpha < 1.f)) { if (hi == 0) wsf[r32] = alpha; asm volatile("s_waitcnt lgkmcnt(0)" ::: "memory");
#pragma unroll
                for (int r = 0; r < 16; ++r) { const float a = wsf[crow(r, hi)];
#pragma unroll
                    for (int d = 0; d < ND0; ++d) o[d][r] *= a; }
                asm volatile("s_waitcnt lgkmcnt(0)" ::: "memory"); }
            bf16x8 pa0, pa1, pa2, pa3;
#define PK4(P, BASE, OUT) do { unsigned a0 = cvt_pk_bf16(P[BASE + 0], P[BASE + 1]), a1 = cvt_pk_bf16(P[BASE + 2], P[BASE + 3]); \
        unsigned b0_ = cvt_pk_bf16(P[BASE + 4], P[BASE + 5]), b1_ = cvt_pk_bf16(P[BASE + 6], P[BASE + 7]); \
        auto r0 = __builtin_amdgcn_permlane32_swap(a0, b0_, false, false); auto r1 = __builtin_amdgcn_permlane32_swap(a1, b1_, false, false); \
        u32x4 w = {r0[0], r1[0], r0[1], r1[1]}; OUT = *reinterpret_cast<bf16x8*>(&w); } while (0)
            PK4(p0, 0, pa0); PK4(p0, 8, pa1); PK4(p1, 0, pa2); PK4(p1, 8, pa3);
#undef PK4
            SBAR();
            const int vb = vb0 + buf * SHM_V;
            if (TYPE == 0) { pv_one<0>(o[0], vb, pa0, pa1, pa2, pa3); pv_one<1>(o[1], vb, pa0, pa1, pa2, pa3); pv_one<2>(o[ND0 - 2], vb, pa0, pa1, pa2, pa3); pv_one<3>(o[ND0 - 1], vb, pa0, pa1, pa2, pa3); }
            else if (cs == 0) { pv_one<0>(o[0], vb, pa0, pa1, pa2, pa3); pv_one<1>(o[1], vb, pa0, pa1, pa2, pa3); }
            else { pv_one<2>(o[0], vb, pa0, pa1, pa2, pa3); pv_one<3>(o[1], vb, pa0, pa1, pa2, pa3); }
        }
        __syncthreads();
    }
    if (hi == 0) wsf[r32] = l_reg; asm volatile("s_waitcnt lgkmcnt(0)" ::: "memory");
    float* Tt = (float*)lds;
    const float sgn = mp == 0 ? 1.f : -T.lam;
    float rli[16];
#pragma unroll
    for (int r = 0; r < 16; ++r) rli[r] = sgn * __builtin_amdgcn_rcpf(wsf[crow(r, hi)]);
    if (mp == 0) {
#pragma unroll
        for (int r = 0; r < 16; ++r)
#pragma unroll
            for (int d = 0; d < ND0; ++d) Tt[(rg * 32 + crow(r, hi)) * 128 + (cs * 2 + d) * 32 + r32] = o[d][r] * rli[r];
    }
    __syncthreads();
    if (mp == 1) {
#pragma unroll
        for (int r = 0; r < 16; ++r)
#pragma unroll
            for (int d = 0; d < ND0; ++d) Tt[(rg * 32 + crow(r, hi)) * 128 + (cs * 2 + d) * 32 + r32] += o[d][r] * rli[r];
    }
    __syncthreads();
    constexpr int RPW = (TYPE == 0 ? 128 : 64) / 8;
    const f32x2 gs = *(const f32x2*)(T.g_subln + lane * 2);
#pragma unroll 4
    for (int i = 0; i < RPW; ++i) { const int row = wid * RPW + i; const f32x2 v = *(const f32x2*)(Tt + row * 128 + lane * 2);
        const float ss = wave_sum(v.x * v.x + v.y * v.y); const float rstd = 0.8f / sqrtf(ss * (1.0f / 128.0f) + SUBLN_EPS);
        *(unsigned*)(T.MIX + (size_t)(qrow0 + row) * 2048 + 1024 + h * 128 + lane * 2) = cvt_pk_bf16(v.x * rstd * gs.x, v.y * rstd * gs.y); }
    __syncthreads();
#undef KROW0
#undef SLOAD
#undef SWRITE
}
#undef KSWZ
#undef SBAR
}

__device__ __forceinline__ void transpose_item(const float* W, int K, int N, bf16_t* WT, int k0, int n0, int dst_row0, LAS float* scr, int lane) {
#pragma unroll 8
    for (int i = 0; i < 32; ++i) { const int kk = 2 * i + (lane >> 5); scr[kk * 33 + (lane & 31)] = W[(size_t)(k0 + kk) * N + n0 + (lane & 31)]; }
    asm volatile("s_waitcnt lgkmcnt(0)" ::: "memory");
    const int c = lane & 7;
#pragma unroll
    for (int j = 0; j < 4; ++j) { const int n = (lane >> 3) + 8 * j; const LAS float* s = scr + (8 * c) * 33 + n;
        u32x4 o; o.x = cvt_pk_bf16(s[0 * 33], s[1 * 33]); o.y = cvt_pk_bf16(s[2 * 33], s[3 * 33]); o.z = cvt_pk_bf16(s[4 * 33], s[5 * 33]); o.w = cvt_pk_bf16(s[6 * 33], s[7 * 33]);
        *(u32x4*)(WT + (size_t)(dst_row0 + n) * K + k0 + 8 * c) = o; }
    asm volatile("s_waitcnt lgkmcnt(0)" ::: "memory");
}
__device__ __forceinline__ void rms_row_to_bf16(const float* xrow, const float* g, bf16_t* orow, int lane) {
    f32x4 v[8]; float s = 0.f;
#pragma unroll
    for (int j = 0; j < 8; ++j) { v[j] = *((const f32x4*)xrow + lane + 64 * j); s += (v[j][0] * v[j][0] + v[j][1] * v[j][1]) + (v[j][2] * v[j][2] + v[j][3] * v[j][3]); }
    const float rstd = 1.0f / sqrtf(wave_sum(s) * (1.0f / DM) + EPS);
#pragma unroll
    for (int j = 0; j < 8; ++j) { const f32x4 gg = *((const f32x4*)g + lane + 64 * j); const f32x4 y = v[j] * rstd * gg; u32x2 w; w.x = cvt_pk_bf16(y[0], y[1]); w.y = cvt_pk_bf16(y[2], y[3]);
        *((u32x2*)orow + lane + 64 * j) = w; }
}

struct Args {
    const float *x_prompt, *x_sample, *cache_k, *cache_v, *state_pool, *meta, *g_mix, *w_in, *w_pool, *pool_scale, *lq1, *lk1, *lq2, *lk2, *g_subln, *w_out, *g_ffn, *w_gate, *w_up, *w_down, *rel_bias, *g_final;
    float* out; unsigned char* ws;
};
constexpr int LDS_BYTES = 147456;

__global__ void __launch_bounds__(512, 2) fwd_kernel(Args a) {
    extern __shared__ __attribute__((aligned(16))) unsigned char lds[];
    cg::grid_group grid = cg::this_grid();
    int wave0_ = __builtin_amdgcn_readfirstlane(threadIdx.x >> 6);
#define PH_BEGIN \
    int wave = wave0_; asm volatile("" : "+s"(wave)); \
    int tid = wave * 64 + (int)__builtin_amdgcn_mbcnt_hi(~0u, __builtin_amdgcn_mbcnt_lo(~0u, 0u)); asm volatile("" : "+v"(tid)); \
    const int lane = tid & 63; \
    int G = gridDim.x, bx = blockIdx.x; asm volatile("" : "+s"(G), "+s"(bx)); \
    const int vcu = (G % 8 == 0) ? (bx % 8) * (G / 8) + bx / 8 : bx; \
    unsigned char* ws = a.ws; asm volatile("" : "+s"(ws)); \
    const int gw = vcu * 8 + wave, NGW = G * 8, gt = bx * 512 + tid, NGT = G * 512; \
    (void)lane; (void)gw; (void)NGW; (void)gt; (void)NGT; (void)vcu;
#define WSP(T, off) ((T*)(ws + (off)))
#define SS1 ((float*)(ws + WS_CTL) + CW_SS1)
#define SS2 ((float*)(ws + WS_CTL) + CW_SS2)

    {
        PH_BEGIN
        LAS float* scr = (LAS float*)((LAS unsigned char*)lds + wave * 16384);
        constexpr int I_IN = (DM / 64) * (INW / 32), I_OUT = (DM / 64) * (DM / 32), I_G = (DM / 64) * (DFF / 32), I_D = (DFF / 64) * (DM / 32), I_P = 4 * (256 / 64) * (256 / 32);
        constexpr int NIT = I_IN + I_OUT + 2 * I_G + I_D + I_P;
        for (int it = gw; it < NIT; it += NGW) {
            int r = it;
            if (r < I_IN) { const int nb = INW / 32, kb = r / nb, n0 = (r % nb) * 32; transpose_item(a.w_in, DM, INW, WSP(bf16_t, WS_WINT), kb * 64, n0, n0, scr, lane); continue; } r -= I_IN;
            if (r < I_OUT) { const int nb = DM / 32, kb = r / nb, n0 = (r % nb) * 32; transpose_item(a.w_out, DM, DM, WSP(bf16_t, WS_WOUTT), kb * 64, n0, n0, scr, lane); continue; } r -= I_OUT;
            if (r < I_G) { const int nb = DFF / 32, kb = r / nb, n0 = (r % nb) * 32; transpose_item(a.w_gate, DM, DFF, WSP(bf16_t, WS_WGUT), kb * 64, n0, (n0 >> 7) * 256 + (n0 & 127), scr, lane); continue; } r -= I_G;
            if (r < I_G) { const int nb = DFF / 32, kb = r / nb, n0 = (r % nb) * 32; transpose_item(a.w_up, DM, DFF, WSP(bf16_t, WS_WGUT), kb * 64, n0, (n0 >> 7) * 256 + 128 + (n0 & 127), scr, lane); continue; } r -= I_G;
            if (r < I_D) { const int nb = DM / 32, kb = r / nb, n0 = (r % nb) * 32; transpose_item(a.w_down, DFF, DM, WSP(bf16_t, WS_WDT), kb * 64, n0, n0, scr, lane); continue; } r -= I_D;
            { const int g = r / 32, q = r % 32, kb = q / 8, n0 = (q % 8) * 32; transpose_item(a.w_pool + (size_t)g * 65536, 256, 256, WSP(bf16_t, WS_WPT) + (size_t)g * 65536, kb * 64, n0, n0, scr, lane); }
        }
        for (int m = gw; m < MPAD; m += NGW) {
            bf16_t* orow = WSP(bf16_t, WS_XN) + (size_t)m * DM;
            if (m < ROW_S0) rms_row_to_bf16(a.x_prompt + (size_t)m * DM, a.g_mix, orow, lane);
            else if (m < ROW_M0) rms_row_to_bf16(a.x_sample + (size_t)(m - ROW_S0) * DM, a.g_mix, orow, lane);
            else if (m < ROW_M0 + NMETA) rms_row_to_bf16(a.meta + (size_t)(m - ROW_M0) * DM, a.g_mix, orow, lane);
            else { for (int j = 0; j < 4; ++j) *((u32x4*)orow + lane + 64 * j) = (u32x4){0u, 0u, 0u, 0u}; }
        }
        { const long n8 = (long)DB * LC * 128;
          for (long i = gt; i < 2 * n8; i += NGT) { const bool isk = i < n8; const long j = isk ? i : i - n8; const long row = j >> 7; const int c8 = (int)(j & 127); const int b = (int)(row / LC), key = (int)(row % LC);
              const float* src = (isk ? a.cache_k : a.cache_v) + j * 8; const f32x4 x0 = *(const f32x4*)src, x1 = *(const f32x4*)(src + 4);
              *(u32x4*)(WSP(bf16_t, isk ? WS_KS : WS_VS) + ((size_t)b * LS + key) * 1024 + c8 * 8) = pack8(x0, x1); } }
        { const int n8 = DB * 15 * 128;
          for (int i = gt; i < n8; i += NGT) { const int row = i >> 7, c8 = i & 127, b = row / 15, j = row % 15; const float* src = a.state_pool + (size_t)i * 8;
              *(u32x4*)(WSP(bf16_t, WS_US) + ((size_t)b * 79 + j) * 1024 + c8 * 8) = pack8(*(const f32x4*)src, *(const f32x4*)(src + 4)); } }
    }
    grid.sync();

    {
        PH_BEGIN
        pg8::Gemm g{WSP(bf16_t, WS_XN), WSP(bf16_t, WS_WINT), DM, DM, DM, 0}; pg8::StaticOrder S; S.init(MPAD / 256, INW / 256, G, bx);
        EpiInProj E{WSP(bf16_t, WS_Q), WSP(bf16_t, WS_KP), WSP(bf16_t, WS_VP), WSP(bf16_t, WS_KS), WSP(bf16_t, WS_VS), WSP(bf16_t, WS_UP), WSP(bf16_t, WS_US), a.out};
        pg8::gemm_phase<EpiInProj>((LAS unsigned char*)lds, tid, g, S, E);
    }
    grid.sync();

    {
        PH_BEGIN
        for (int i = gt; i < MROWS * 128; i += NGT) {
            const int r = i >> 7, c8 = i & 127, gidx = c8 >> 5, w = 2 << gidx;
            const bf16_t* up = r < ROW_S0 ? WSP(bf16_t, WS_UP) + ((size_t)(r >> 11) * LP + 16 + (r & 2047)) * 1024 + c8 * 8 : WSP(bf16_t, WS_US) + ((size_t)((r - ROW_S0) >> 6) * 79 + 15 + ((r - ROW_S0) & 63)) * 1024 + c8 * 8;
            float s[8], u0[8];
            { const bf16x8 v = *(const bf16x8*)up;
#pragma unroll
              for (int e = 0; e < 8; ++e) { u0[e] = bf2f((unsigned short)v[e]); s[e] = u0[e]; } }
            for (int j = 1; j < w; ++j) { const bf16x8 v = *(const bf16x8*)(up - (size_t)j * 1024);
#pragma unroll
                for (int e = 0; e < 8; ++e) s[e] += bf2f((unsigned short)v[e]); }
            const float inv = 1.0f / (float)w; f32x4 p0, p1;
#pragma unroll
            for (int e = 0; e < 4; ++e) { p0[e] = s[e] * inv - u0[e]; p1[e] = s[4 + e] * inv - u0[4 + e]; }
            *(u32x4*)(WSP(bf16_t, WS_P) + (size_t)r * 1024 + c8 * 8) = pack8(p0, p1);
        }
    }
    grid.sync();

    {
        PH_BEGIN
        pg8::Gemm g{WSP(bf16_t, WS_P), WSP(bf16_t, WS_WPT), 1024, 256, 256, 256}; pg8::StaticOrder S; S.init(MROWS / 256, 4, G, bx);
        EpiPool E{WSP(bf16_t, WS_MIX), a.pool_scale};
        pg8::gemm_phase<EpiPool>((LAS unsigned char*)lds, tid, g, S, E);
    }
    {
        PH_BEGIN
        const float d1 = wave_sum(a.lq1[lane] * a.lk1[lane]), d2 = wave_sum(a.lq2[lane] * a.lk2[lane]);
        att::Tensors T{WSP(bf16_t, WS_Q), WSP(bf16_t, WS_KP), WSP(bf16_t, WS_VP), WSP(bf16_t, WS_KS), WSP(bf16_t, WS_VS), WSP(bf16_t, WS_MIX), a.rel_bias, a.g_subln, __expf(d1) - __expf(d2) + 0.2f};
        for (int j = vcu; j < 256 + 128; j += G) {
            if (j < 256) { const int bh = j >> 3, s = j & 7; att::attn_unit<0>((char*)lds, tid, T, bh >> 3, bh & 7, 15 - s); att::attn_unit<0>((char*)lds, tid, T, bh >> 3, bh & 7, s); }
            else { const int bh = j - 256; att::attn_unit<1>((char*)lds, tid, T, bh >> 3, bh & 7, 0); }
        }
    }
    grid.sync();

    {
        PH_BEGIN
        pg8::Gemm g{WSP(bf16_t, WS_MIX), WSP(bf16_t, WS_WOUTT), DM, DM, DM, 0}; pg8::StaticOrder S; S.init(MROWS / 256, DM / 256, G, bx);
        EpiOutProj E{a.x_prompt, a.x_sample, a.g_ffn, WSP(float, WS_H1), WSP(bf16_t, WS_XN), SS1};
        pg8::gemm_phase<EpiOutProj>((LAS unsigned char*)lds, tid, g, S, E);
    }
    grid.sync();

    {
        PH_BEGIN
        pg8::Gemm g{WSP(bf16_t, WS_XN), WSP(bf16_t, WS_WGUT), DM, DM, DM, 0}; pg8::StaticOrder S; S.init(MROWS / 256, 2 * DFF / 256, G, bx);
        EpiFFN1 E{WSP(bf16_t, WS_HMID), SS1};
        pg8::gemm_phase<EpiFFN1>((LAS unsigned char*)lds, tid, g, S, E);
    }
    grid.sync();

    {
        PH_BEGIN
        pg8::Gemm g{WSP(bf16_t, WS_HMID), WSP(bf16_t, WS_WDT), DFF, DFF, DFF, 0}; pg8::StaticOrder S; S.init(MROWS / 256, DM / 256, G, bx);
        EpiDown E{WSP(float, WS_H1), a.out + O_Y, SS2};
        pg8::gemm_phase<EpiDown>((LAS unsigned char*)lds, tid, g, S, E);
    }
    grid.sync();

    {
        PH_BEGIN
        for (int m = gw; m < MROWS; m += NGW) {
            float* yr = a.out + O_Y + (size_t)m * DM; const float rstd = 1.0f / sqrtf(SS2[m] * (1.0f / DM) + EPS);
#pragma unroll
            for (int j = 0; j < 8; ++j) { const f32x4 gg = *((const f32x4*)a.g_final + lane + 64 * j); f32x4* p = (f32x4*)yr + lane + 64 * j; *p = *p * rstd * gg; }
        }
    }
}

extern "C" void kernel_launch(void* const* d_in, const int* in_sizes, int n_in, void* d_out, int out_size, void* d_ws, size_t ws_size, hipStream_t stream) {
    static int grid = 0;
    if (grid == 0) {
        if (n_in != 22 || out_size != (int)O_END || ws_size < WS_END) { fprintf(stderr, "kernel_launch: unexpected shapes: n_in %d out %d ws %zu\n", n_in, out_size, ws_size); grid = -1; return; }
        int dev = 0, cus = 0, per_cu = 0;
        hipGetDevice(&dev); hipDeviceGetAttribute(&cus, hipDeviceAttributeMultiprocessorCount, dev);
        if (hipFuncSetAttribute((const void*)fwd_kernel, hipFuncAttributeMaxDynamicSharedMemorySize, LDS_BYTES) != hipSuccess) { fprintf(stderr, "kernel_launch: hipFuncSetAttribute failed\n"); grid = -1; return; }
        hipOccupancyMaxActiveBlocksPerMultiprocessor(&per_cu, (const void*)fwd_kernel, 512, LDS_BYTES);
        if (per_cu < 1) { fprintf(stderr, "kernel_launch: occupancy query says %d blocks per CU\n", per_cu); grid = -1; return; }
        grid = cus;
    }
    if (grid < 0) return;
    hipMemsetAsync((char*)d_ws + WS_CTL, 0, CTL_BYTES, stream);
    Args a{};
    const float** p = (const float**)&a;
    for (int i = 0; i < 22; ++i) p[i] = (const float*)d_in[i];
    a.out = (float*)d_out; a.ws = (unsigned char*)d_ws;
    void* args[] = {&a};
    hipError_t e = hipLaunchCooperativeKernel((const void*)fwd_kernel, dim3(grid), dim3(512), args, LDS_BYTES, stream);
    if (e != hipSuccess) fprintf(stderr, "cooperative launch failed: %s (grid %d)\n", hipGetErrorString(e), grid);
}
```

```cpp
#include <hip/hip_runtime.h>
#include <hip/hip_cooperative_groups.h>
#include <cstdio>
#include <cstdint>
namespace cg = cooperative_groups;

constexpr int DM = 2048, NB = 4, SEQ = 2048, DB = 16, DSEQ = 64, PAST = 2048, NMETA = 16;
constexpr int LP = NMETA + SEQ;
constexpr int LC = NMETA + PAST;
constexpr int LS = LC + DSEQ;
constexpr int PW = 1024, QKW = 1024, AW = 1024, INW = 4096, DFF = 5632, NH = 8;
constexpr int MROWS = NB * SEQ + DB * DSEQ;
constexpr int MPAD = 9472;
constexpr int ROW_S0 = NB * SEQ;
constexpr int ROW_M0 = MROWS;
constexpr float EPS = 1e-6f, SUBLN_EPS = 1e-5f;
constexpr float LOG2E = 1.4426950408889634f;
constexpr float QSCALE = 0.125f * LOG2E;

constexpr size_t O_Y = 0;
constexpr size_t O_KP = (size_t)MROWS * DM;
constexpr size_t O_VP = O_KP + (size_t)NB * LP * 1024;
constexpr size_t O_PP = O_VP + (size_t)NB * LP * 1024;
constexpr size_t O_KS = O_PP + (size_t)NB * 15 * 1024;
constexpr size_t O_VS = O_KS + (size_t)DB * DSEQ * 1024;
constexpr size_t O_PS = O_VS + (size_t)DB * DSEQ * 1024;
constexpr size_t O_END = O_PS + (size_t)DB * 15 * 1024;

constexpr size_t MiB = 1u << 20;
constexpr size_t WS_CTL = 0, CTL_BYTES = 1 * MiB;
constexpr size_t WS_WINT = 1 * MiB, WS_WOUTT = 17 * MiB, WS_WGUT = 25 * MiB, WS_WDT = 69 * MiB, WS_WPT = 91 * MiB;
constexpr size_t WS_XN = 92 * MiB;
constexpr size_t WS_Q = 129 * MiB;
constexpr size_t WS_KP = 148 * MiB, WS_VP = 165 * MiB;
constexpr size_t WS_UP = 182 * MiB;
constexpr size_t WS_US = 199 * MiB;
constexpr size_t WS_P = 202 * MiB;
constexpr size_t WS_MIX = 220 * MiB;
constexpr size_t WS_H1 = 256 * MiB;
constexpr size_t WS_KS = 328 * MiB, WS_VS = 395 * MiB;
constexpr size_t WS_HMID = 328 * MiB;
constexpr size_t WS_END = 462 * MiB;
constexpr int CW_SS1 = 16384, CW_SS2 = 32768;
constexpr int CW_BAR = 4096;
constexpr int CW_QATT = 64;

typedef unsigned short bf16_t;
typedef short bf16x8 __attribute__((ext_vector_type(8)));
typedef short s16x4 __attribute__((ext_vector_type(4)));
typedef float f32x4 __attribute__((ext_vector_type(4)));
typedef float f32x2 __attribute__((ext_vector_type(2)));
typedef float f32x16 __attribute__((ext_vector_type(16)));
typedef unsigned u32x4 __attribute__((ext_vector_type(4)));
typedef unsigned u32x2 __attribute__((ext_vector_type(2)));
#define LAS __attribute__((address_space(3)))

__device__ __forceinline__ unsigned cvt_pk_bf16(float lo, float hi) { unsigned r; asm volatile("v_cvt_pk_bf16_f32 %0, %1, %2" : "=v"(r) : "v"(lo), "v"(hi)); return r; }
__device__ __forceinline__ float bf2f(unsigned short h) { return __uint_as_float((unsigned)h << 16); }
__device__ __forceinline__ float wave_sum(float v) {
#pragma unroll
    for (int o = 1; o < 64; o <<= 1) v += __shfl_xor(v, o);
    return v;
}


#define XB_TMO      128
#define XB_XCNT(j)  (256  + 64 * (j))
#define XB_XSUB(j)  (1280 + 64 * (j))
#define XB_XGEN(j)  (2304 + 64 * (j))
#define XB_TOP      3328
#define XB_TOPGEN   3392
#define XCD_BAR_WORDS 3456
#define XB_SPIN_CAP (1u << 18)
__device__ __forceinline__ unsigned xb_ld(unsigned* p)              { return __hip_atomic_load(p, __ATOMIC_RELAXED, __HIP_MEMORY_SCOPE_AGENT); }
__device__ __forceinline__ unsigned xb_add(unsigned* p, unsigned v) { return __hip_atomic_fetch_add(p, v, __ATOMIC_RELAXED, __HIP_MEMORY_SCOPE_AGENT); }
__device__ __forceinline__ unsigned xb_xcc_id() { return (unsigned)__builtin_amdgcn_s_getreg((3 << 11) | 20) & 0xFu; }
#define XB_SPIN(cond, bar) do { unsigned _sp = 0; while (cond) { __builtin_amdgcn_s_sleep(1); \
    if ((++_sp & 255u) == 0u) { if (xb_ld(&(bar)[XB_TMO])) break; if (_sp > XB_SPIN_CAP) { atomicAdd(&(bar)[XB_TMO], 1u); break; } } } } while (0)
__device__ __forceinline__ void xcd_barrier_complete(unsigned* bar, unsigned x, unsigned& nloc, unsigned& nx) {
    const unsigned G = gridDim.x * gridDim.y * gridDim.z;
    unsigned sum, cnt, mine, sp = 0u;
    for (;;) {
        sum = 0u; cnt = 0u; mine = 0u;
#pragma unroll
        for (unsigned j = 0; j < 16; ++j) { const unsigned c = xb_ld(&bar[XB_XCNT(j)]); sum += c; cnt += (c > 0u) ? 1u : 0u; mine = (j == x) ? c : mine; }
        if (sum == G) break;
        __builtin_amdgcn_s_sleep(1);
        if ((++sp & 255u) == 0u) { if (xb_ld(&bar[XB_TMO])) break; if (sp > XB_SPIN_CAP) { atomicAdd(&bar[XB_TMO], 1u); break; } }
    }
    nloc = mine > 0u ? mine : 1u; nx = cnt > 0u ? cnt : 1u;
}
__device__ __forceinline__ void xcd_barrier(unsigned* bar, volatile LAS unsigned* st, bool is_t0) {
    asm volatile("s_waitcnt vmcnt(0)" ::: "memory");
    __syncthreads();
    if (is_t0) {
        const unsigned x = xb_xcc_id();
        __builtin_amdgcn_s_waitcnt(0);
        unsigned nloc = st[0], nx = st[1];
        if (nloc == 0u) { xcd_barrier_complete(bar, x, nloc, nx); st[0] = nloc; st[1] = nx; }
        const unsigned old = xb_add(&bar[XB_XSUB(x)], 1u);
        const unsigned gen = old / nloc;
        if (old + 1u == (gen + 1u) * nloc) {
            __builtin_amdgcn_fence(__ATOMIC_RELEASE, "agent");
            asm volatile("s_waitcnt vmcnt(0)" ::: "memory");
            const unsigned og = xb_add(&bar[XB_TOP], 1u);
            const unsigned tg = og / nx;
            if (og + 1u == (tg + 1u) * nx) xb_add(&bar[XB_TOPGEN], 1u);
            else XB_SPIN(xb_ld(&bar[XB_TOPGEN]) == tg, bar);
            __builtin_amdgcn_fence(__ATOMIC_ACQUIRE, "agent");
            xb_add(&bar[XB_XGEN(x)], 1u);
            asm volatile("s_waitcnt vmcnt(0)" ::: "memory");
        } else {
            XB_SPIN(xb_ld(&bar[XB_XGEN(x)]) == gen, bar);
            __builtin_amdgcn_fence(__ATOMIC_ACQUIRE, "agent");
            asm volatile("s_waitcnt vmcnt(0)" ::: "memory");
        }
    }
    __syncthreads();
}

namespace pg8 {
constexpr int BM = 256, BK = 64, HALF = 128, HTB = HALF * BK * 2, STAGE_BYTES = 8 * HTB, NXCD = 8, WGM = 8;
__host__ __device__ __forceinline__ int lds_byte(int r, int c) { const int st = (r >> 4) * 2 + (c >> 5), rr = r & 15, cc = c & 31, ob = rr * 64 + cc * 2; return st * 1024 + (ob ^ (((ob >> 9) & 1) << 5)); }
__host__ __device__ __forceinline__ void stage_rc(int b, int& R, int& C) { const int st = b / 1024, sb = b % 1024, swz = sb ^ (((sb >> 9) & 1) << 5); R = (st >> 1) * 16 + swz / 64; C = (st & 1) * 32 + (swz % 64) / 2; }
__host__ __device__ __forceinline__ int perm32(int rho) { const int n = rho >> 4, i = rho & 15; return 8 * (i >> 2) + 4 * n + (i & 3); }

struct Unit { int pm, pn; };
struct Gemm { const bf16_t* A; const bf16_t* Bt; int lda, ldb, K, a_pn_off; };

struct StaticOrder {
    int nM, nN, nwg, G, c;
    __device__ void init(int nM_, int nN_, int G_, int c_) { nM = nM_; nN = nN_; nwg = nM * nN; G = G_; c = c_; }
    __device__ bool next(int i, Unit& u) const {
        const long L = (long)i * G + c; if (L >= nwg) return false;
        int wgid = (int)L; { const int q = nwg / NXCD, r = nwg % NXCD, xcd = wgid % NXCD, off = wgid / NXCD; wgid = (xcd < r ? xcd * (q + 1) : r * (q + 1) + (xcd - r) * q) + off; }
        const int nig = WGM * nN, gid = wgid / nig, fm = gid * WGM, gsz = (nM - fm) < WGM ? (nM - fm) : WGM;
        u.pm = fm + ((wgid % nig) % gsz); u.pn = (wgid % nig) / gsz; return true;
    }
};

template <class Epi>
__device__ __forceinline__ void gemm_phase(LAS unsigned char* lds, const int tid, const Gemm g, const StaticOrder& S, const Epi& E) {
    const int wid = __builtin_amdgcn_readfirstlane(tid >> 6), lane = tid & 63, wr = wid >> 2, wc = wid & 3, fr = lane & 15, fq = lane >> 4;
    const int K = g.K, nt = K / BK;
    unsigned voffA[2], voffB[2];
#pragma unroll
    for (int i = 0; i < 2; ++i) { int R, C; stage_rc(tid * 16 + i * 8192, R, C); const int Rb = Epi::PERM ? ((R & ~31) + perm32(R & 31)) : R;
        voffA[i] = (unsigned)(R * g.lda + C) * 2u; voffB[i] = (unsigned)(Rb * g.ldb + C) * 2u; }
    const size_t kstep = (size_t)(BK * 2);
    const size_t hstepA = (size_t)HALF * g.lda * 2, hstepB = (size_t)HALF * g.ldb * 2;
    const size_t tstepA = 2 * hstepA, tstepB = 2 * hstepB;
    const unsigned ldsw = (unsigned)wid * 1024u;
    const int aoff = lds_byte(wr * 64 + fr, fq * 8), boff = lds_byte(wc * 32 + fr, fq * 8);
#define PG8_SA(b, h) (((b) * 2 + (h)) * HTB)
#define PG8_SB(b, h) ((4 + (b) * 2 + (h)) * HTB)
#define PG8_STAGE(bufoff, gbase, voff) do { _Pragma("unroll") for (int _i = 0; _i < 2; ++_i) \
        __builtin_amdgcn_global_load_lds((const unsigned*)((const char*)(gbase) + (voff)[_i]), (LAS unsigned*)(lds + (bufoff) + ldsw + _i * 8192), 16, 0, 0); } while (0)
#define PG8_LDA(dst, b, h) do { _Pragma("unroll") for (int m = 0; m < 4; ++m) _Pragma("unroll") for (int k = 0; k < 2; ++k) dst[m][k] = *(const LAS bf16x8*)(lds + PG8_SA(b, h) + aoff + m * 2048 + k * 1024); } while (0)
#define PG8_LDB(dst, b, h) do { _Pragma("unroll") for (int n = 0; n < 2; ++n) _Pragma("unroll") for (int k = 0; k < 2; ++k) dst[n][k] = *(const LAS bf16x8*)(lds + PG8_SB(b, h) + boff + n * 2048 + k * 1024); } while (0)
#define PG8_MMA(ai, bj, At, Bt) do { __builtin_amdgcn_s_setprio(1); _Pragma("unroll") for (int m = 0; m < 4; ++m) _Pragma("unroll") for (int n = 0; n < 2; ++n) _Pragma("unroll") for (int k = 0; k < 2; ++k) \
        acc[ai][bj][m][n] = __builtin_amdgcn_mfma_f32_16x16x32_bf16(Bt[n][k], At[m][k], acc[ai][bj][m][n], 0, 0, 0); __builtin_amdgcn_s_setprio(0); } while (0)
#define PG8_WAIT_V(n) asm volatile("s_waitcnt vmcnt(" #n ")" ::: "memory")
#define PG8_WAIT_L(n) asm volatile("s_waitcnt lgkmcnt(" #n ")" ::: "memory")
#define PG8_BAR __builtin_amdgcn_s_barrier()
#define PG8_SCHED __builtin_amdgcn_sched_barrier(0)
    Unit cur, nxt; int ui = 0;
    if (!S.next(0, cur)) return;
    f32x4 acc[2][2][4][2];
#pragma unroll
    for (int a = 0; a < 2; ++a)
#pragma unroll
        for (int b = 0; b < 2; ++b)
#pragma unroll
            for (int m = 0; m < 4; ++m)
#pragma unroll
                for (int n = 0; n < 2; ++n) acc[a][b][m][n] = (f32x4){0.f, 0.f, 0.f, 0.f};
    bf16x8 At[4][2], B0[2][2], B1[2][2];
    const char* cA = (const char*)g.A + (size_t)cur.pm * tstepA + (size_t)cur.pn * g.a_pn_off * 2; const char* cB = (const char*)g.Bt + (size_t)cur.pn * tstepB;
    PG8_STAGE(PG8_SB(0, 0), cB, voffB); PG8_STAGE(PG8_SB(0, 1), cB + hstepB, voffB); PG8_STAGE(PG8_SA(0, 0), cA, voffA); PG8_STAGE(PG8_SA(0, 1), cA + hstepA, voffA);
    if (wr == 1) PG8_BAR;
    PG8_WAIT_V(2); PG8_BAR;
    PG8_STAGE(PG8_SB(1, 0), cB + kstep, voffB); PG8_STAGE(PG8_SA(1, 0), cA + kstep, voffA); PG8_STAGE(PG8_SB(1, 1), cB + hstepB + kstep, voffB);
    PG8_WAIT_V(6); PG8_BAR;
    for (;;) {
        const bool has_next = S.next(ui + 1, nxt);
        const char* nA = has_next ? (const char*)g.A + (size_t)nxt.pm * tstepA + (size_t)nxt.pn * g.a_pn_off * 2 : cA; const char* nB = has_next ? (const char*)g.Bt + (size_t)nxt.pn * tstepB : cB;
        for (int t = 0; t < nt; t += 2) {
            const bool last = (t == nt - 2);
            const char* a1 = cA + (size_t)(t + 1) * kstep;
            const char* a2 = last ? nA : cA + (size_t)(t + 2) * kstep; const char* b2 = last ? nB : cB + (size_t)(t + 2) * kstep;
            const char* a3 = a2 + kstep; const char* b3 = b2 + kstep;
            PG8_LDB(B0, 0, 0); PG8_LDB(B1, 0, 1); PG8_SCHED; PG8_LDA(At, 0, 0); PG8_STAGE(PG8_SA(1, 1), a1 + hstepA, voffA);
            PG8_WAIT_V(8); PG8_WAIT_L(0); PG8_BAR; PG8_MMA(0, 0, At, B0); PG8_MMA(0, 1, At, B1); PG8_BAR; PG8_SCHED;
            PG8_LDA(At, 0, 1); PG8_STAGE(PG8_SB(0, 0), b2, voffB); PG8_STAGE(PG8_SB(0, 1), b2 + hstepB, voffB); PG8_STAGE(PG8_SA(0, 0), a2, voffA);
            PG8_WAIT_V(8); PG8_WAIT_L(0); PG8_BAR; PG8_MMA(1, 0, At, B0); PG8_MMA(1, 1, At, B1); PG8_BAR; PG8_SCHED;
            PG8_LDB(B0, 1, 0); PG8_LDB(B1, 1, 1); PG8_SCHED; PG8_LDA(At, 1, 0); PG8_STAGE(PG8_SA(0, 1), a2 + hstepA, voffA);
            PG8_WAIT_V(8); PG8_WAIT_L(0); PG8_BAR; PG8_MMA(0, 0, At, B0); PG8_MMA(0, 1, At, B1); PG8_BAR; PG8_SCHED;
            PG8_LDA(At, 1, 1); PG8_STAGE(PG8_SB(1, 0), b3, voffB); PG8_STAGE(PG8_SB(1, 1), b3 + hstepB, voffB); PG8_STAGE(PG8_SA(1, 0), a3, voffA);
            PG8_WAIT_V(8); PG8_WAIT_L(0); PG8_BAR; PG8_MMA(1, 0, At, B0); PG8_MMA(1, 1, At, B1); PG8_BAR; PG8_SCHED;
        }
        if (wr == 0) PG8_BAR;
        E(acc, cur, wr, wc, fr, fq);
        if (!has_next) break;
#pragma unroll
        for (int a = 0; a < 2; ++a)
#pragma unroll
            for (int b = 0; b < 2; ++b)
#pragma unroll
                for (int m = 0; m < 4; ++m)
#pragma unroll
                    for (int n = 0; n < 2; ++n) acc[a][b][m][n] = (f32x4){0.f, 0.f, 0.f, 0.f};
        cur = nxt; cA = nA; cB = nB; ++ui;
        if (wr == 1) PG8_BAR;
    }
    PG8_WAIT_V(0);
    PG8_BAR;
#undef PG8_SA
#undef PG8_SB
#undef PG8_STAGE
#undef PG8_LDA
#undef PG8_LDB
#undef PG8_MMA
#undef PG8_WAIT_V
#undef PG8_WAIT_L
#undef PG8_BAR
#undef PG8_SCHED
}
}

__device__ __forceinline__ u32x4 pack8(const f32x4 a, const f32x4 b) { u32x4 w; w.x = cvt_pk_bf16(a[0], a[1]); w.y = cvt_pk_bf16(a[2], a[3]); w.z = cvt_pk_bf16(b[0], b[1]); w.w = cvt_pk_bf16(b[2], b[3]); return w; }

struct EpiInProj {
    static constexpr bool PERM = true;
    bf16_t *Qb, *KP, *VP, *UP, *US; float* out;
    __device__ __forceinline__ void operator()(const f32x4 (&acc)[2][2][4][2], const pg8::Unit& u, int wr, int wc, int fr, int fq) const {
        const int region = u.pn >> 2, cb = (u.pn & 3) * 256 + wc * 32 + 8 * fq, cls = u.pm < 32 ? 0 : (u.pm < 36 ? 1 : 2);
        const int row0 = u.pm * 256 + wr * 64 + fr;
#pragma unroll
        for (int ai = 0; ai < 2; ++ai)
#pragma unroll
            for (int m = 0; m < 4; ++m) {
                const int r = row0 + ai * 128 + m * 16;
#pragma unroll
                for (int bj = 0; bj < 2; ++bj) {
                    const int c = cb + bj * 128; const f32x4 v0 = acc[ai][bj][m][0], v1 = acc[ai][bj][m][1];
                    if (region == 1) { *(u32x4*)(Qb + (size_t)r * 1024 + c) = pack8(v0 * QSCALE, v1 * QSCALE); }
                    else if (region == 0) {
                        const u32x4 w = pack8(v0, v1);
                        if (cls == 0) { const int b = r >> 11, i = r & 2047; *(u32x4*)(UP + ((size_t)b * LP + 16 + i) * 1024 + c) = w;
                            if (i >= SEQ - 15) { float* o = out + O_PP + ((size_t)b * 15 + (i - (SEQ - 15))) * 1024 + c; *(f32x4*)o = v0; *(f32x4*)(o + 4) = v1; } }
                        else if (cls == 1) { const int rs = r - ROW_S0, b = rs >> 6, t = rs & 63; *(u32x4*)(US + ((size_t)b * 79 + 15 + t) * 1024 + c) = w;
                            if (t >= DSEQ - 15) { float* o = out + O_PS + ((size_t)b * 15 + (t - (DSEQ - 15))) * 1024 + c; *(f32x4*)o = v0; *(f32x4*)(o + 4) = v1; } }
                        else { const int j = r - ROW_M0; if (j < NMETA) { for (int b = 0; b < NB; ++b) *(u32x4*)(UP + ((size_t)b * LP + j) * 1024 + c) = w; } }
                    } else {
                        const u32x4 w = pack8(v0, v1);
                        bf16_t* Pb = region == 2 ? KP : VP;
                        float* oP = out + (region == 2 ? O_KP : O_VP); float* oS = out + (region == 2 ? O_KS : O_VS);
                        if (cls == 0) { const int b = r >> 11, i = r & 2047; const size_t e = ((size_t)b * LP + 16 + i) * 1024 + c; *(u32x4*)(Pb + e) = w; *(f32x4*)(oP + e) = v0; *(f32x4*)(oP + e + 4) = v1; }
                        else if (cls == 1) { const int rs = r - ROW_S0; const size_t e = (size_t)rs * 1024 + c; *(f32x4*)(oS + e) = v0; *(f32x4*)(oS + e + 4) = v1; }
                        else { const int j = r - ROW_M0; if (j < NMETA) { for (int b = 0; b < NB; ++b) { const size_t e = ((size_t)b * LP + j) * 1024 + c; *(u32x4*)(Pb + e) = w; *(f32x4*)(oP + e) = v0; *(f32x4*)(oP + e + 4) = v1; } } }
                    }
                }
            }
    }
};

struct EpiPool {
    static constexpr bool PERM = true;
    bf16_t* MIX; const float* scale;
    __device__ __forceinline__ void operator()(const f32x4 (&acc)[2][2][4][2], const pg8::Unit& u, int wr, int wc, int fr, int fq) const {
        const int c0 = u.pn * 256 + wc * 32 + 8 * fq, row0 = u.pm * 256 + wr * 64 + fr;
        f32x4 sc[2][2];
#pragma unroll
        for (int bj = 0; bj < 2; ++bj)
#pragma unroll
            for (int n = 0; n < 2; ++n) sc[bj][n] = *(const f32x4*)(scale + c0 + bj * 128 + 4 * n);
#pragma unroll
        for (int ai = 0; ai < 2; ++ai)
#pragma unroll
            for (int m = 0; m < 4; ++m) { const int r = row0 + ai * 128 + m * 16;
#pragma unroll
                for (int bj = 0; bj < 2; ++bj) *(u32x4*)(MIX + (size_t)r * 2048 + c0 + bj * 128) = pack8(acc[ai][bj][m][0] * sc[bj][0], acc[ai][bj][m][1] * sc[bj][1]); }
    }
};

struct EpiOutProj {
    static constexpr bool PERM = false;
    const float *xp, *xs, *gffn; float* H1; bf16_t* XN2; float* ss;
    __device__ __forceinline__ void operator()(const f32x4 (&acc)[2][2][4][2], const pg8::Unit& u, int wr, int wc, int fr, int fq) const {
        const int c0 = u.pn * 256 + wc * 32 + 4 * fq, row0 = u.pm * 256 + wr * 64 + fr;
        const float* xb = u.pm < 32 ? xp : xs - (size_t)ROW_S0 * DM;
        f32x4 gv[2][2];
#pragma unroll
        for (int bj = 0; bj < 2; ++bj)
#pragma unroll
            for (int n = 0; n < 2; ++n) gv[bj][n] = *(const f32x4*)(gffn + c0 + bj * 128 + 16 * n);
#pragma unroll
        for (int ai = 0; ai < 2; ++ai)
#pragma unroll
            for (int m = 0; m < 4; ++m) { const int r = row0 + ai * 128 + m * 16; const size_t off = (size_t)r * DM + c0; float s = 0.f;
#pragma unroll
                for (int bj = 0; bj < 2; ++bj)
#pragma unroll
                    for (int n = 0; n < 2; ++n) { const size_t o = off + bj * 128 + 16 * n; const f32x4 h = *(const f32x4*)(xb + o) + acc[ai][bj][m][n];
                        *(f32x4*)(H1 + o) = h; const f32x4 hg = h * gv[bj][n]; u32x2 w; w.x = cvt_pk_bf16(hg[0], hg[1]); w.y = cvt_pk_bf16(hg[2], hg[3]); *(u32x2*)(XN2 + o) = w;
                        s += (h[0] * h[0] + h[1] * h[1]) + (h[2] * h[2] + h[3] * h[3]); }
                s += __shfl_xor(s, 16); s += __shfl_xor(s, 32);
                if (fq == 0) atomicAdd(ss + r, s);
                if (m & 1) asm volatile("" ::: "memory"); }
    }
};

struct EpiFFN1 {
    static constexpr bool PERM = true;
    bf16_t* HM; const float* ss;
    __device__ __forceinline__ void operator()(const f32x4 (&acc)[2][2][4][2], const pg8::Unit& u, int wr, int wc, int fr, int fq) const {
        const int c0 = u.pn * 128 + wc * 32 + 8 * fq, row0 = u.pm * 256 + wr * 64 + fr;
#pragma unroll
        for (int ai = 0; ai < 2; ++ai)
#pragma unroll
            for (int m = 0; m < 4; ++m) { const int r = row0 + ai * 128 + m * 16; const float rstd = 1.0f / sqrtf(ss[r] * (1.0f / DM) + EPS);
                f32x4 o[2];
#pragma unroll
                for (int n = 0; n < 2; ++n)
#pragma unroll
                    for (int j = 0; j < 4; ++j) { const float gt = acc[ai][0][m][n][j] * rstd, up = acc[ai][1][m][n][j] * rstd;
                        o[n][j] = gt * __builtin_amdgcn_rcpf(1.0f + __builtin_amdgcn_exp2f(-gt * LOG2E)) * up; }
                *(u32x4*)(HM + (size_t)r * DFF + c0) = pack8(o[0], o[1]); }
    }
};

struct EpiDown {
    static constexpr bool PERM = false;
    const float* H1; float* Y; float* ss;
    __device__ __forceinline__ void operator()(const f32x4 (&acc)[2][2][4][2], const pg8::Unit& u, int wr, int wc, int fr, int fq) const {
        const int c0 = u.pn * 256 + wc * 32 + 4 * fq, row0 = u.pm * 256 + wr * 64 + fr;
#pragma unroll
        for (int ai = 0; ai < 2; ++ai)
#pragma unroll
            for (int m = 0; m < 4; ++m) { const int r = row0 + ai * 128 + m * 16; const size_t off = (size_t)r * DM + c0; float s = 0.f;
#pragma unroll
                for (int bj = 0; bj < 2; ++bj)
#pragma unroll
                    for (int n = 0; n < 2; ++n) { const size_t o = off + bj * 128 + 16 * n; const f32x4 h = *(const f32x4*)(H1 + o) + acc[ai][bj][m][n];
                        *(f32x4*)(Y + o) = h; s += (h[0] * h[0] + h[1] * h[1]) + (h[2] * h[2] + h[3] * h[3]); }
                s += __shfl_xor(s, 16); s += __shfl_xor(s, 32);
                if (fq == 0) atomicAdd(ss + r, s);
                if (m & 1) asm volatile("" ::: "memory"); }
    }
};

namespace att {
constexpr int SHM_V = 64 * 128 * 2, SHM_K = 64 * 128 * 2;
constexpr int OFF_V = 0, OFF_K = 2 * SHM_V, OFF_LUT = 2 * SHM_V + 2 * SHM_K, OFF_WS = OFF_LUT + 1024;
constexpr float NEG = -1e30f;
constexpr float THR2 = 8.0f * LOG2E;
#define KSWZ(row, colB) ((row) * 256 + ((colB) ^ (((row) & 7) << 4)))
#define SBAR() __builtin_amdgcn_sched_barrier(0)
__device__ __forceinline__ int crow(int r, int hi) { return (r & 3) + 8 * (r >> 2) + 4 * hi; }
__device__ __forceinline__ int v_st(int k, int c) { const int kk = (k & ~0xC) | ((k & 4) << 1) | ((k & 8) >> 1); return ((kk >> 3) * 4 + (c >> 5)) * 512 + ((kk & 7) * 32 + (c & 31)) * 2; }
__device__ __forceinline__ int v_rd_base(int lane) { return ((lane & 3) << 3) | (((lane >> 2) & 3) << 6) | (((lane >> 4) & 1) << 5) | (((lane >> 5) & 1) << 8); }
constexpr int v_rd_off(int d0, int ks, int half) { return d0 * 512 + ks * 4096 + half * 2048; }
template <int OFF> __device__ __forceinline__ s16x4 tr_read(int vb) {
    s16x4 r; asm volatile("ds_read_b64_tr_b16 %0, %1 offset:%2" : "=&v"(r) : "v"(vb), "i"(OFF) : "memory"); return r;
}
template <int D0> __device__ __forceinline__ void pv_one(f32x16& od, int vb, bf16x8 pa0, bf16x8 pa1, bf16x8 pa2, bf16x8 pa3) {
    const s16x4 l0 = tr_read<v_rd_off(D0, 0, 0)>(vb), h0 = tr_read<v_rd_off(D0, 0, 1)>(vb), l1 = tr_read<v_rd_off(D0, 1, 0)>(vb), h1 = tr_read<v_rd_off(D0, 1, 1)>(vb);
    const s16x4 l2 = tr_read<v_rd_off(D0, 2, 0)>(vb), h2 = tr_read<v_rd_off(D0, 2, 1)>(vb), l3 = tr_read<v_rd_off(D0, 3, 0)>(vb), h3 = tr_read<v_rd_off(D0, 3, 1)>(vb);
    asm volatile("s_waitcnt lgkmcnt(0)" ::: "memory"); SBAR();
#define PK(L, H) (bf16x8){L[0], L[1], L[2], L[3], H[0], H[1], H[2], H[3]}
    od = __builtin_amdgcn_mfma_f32_32x32x16_bf16(pa0, PK(l0, h0), od, 0, 0, 0);
    od = __builtin_amdgcn_mfma_f32_32x32x16_bf16(pa1, PK(l1, h1), od, 0, 0, 0);
    od = __builtin_amdgcn_mfma_f32_32x32x16_bf16(pa2, PK(l2, h2), od, 0, 0, 0);
    od = __builtin_amdgcn_mfma_f32_32x32x16_bf16(pa3, PK(l3, h3), od, 0, 0, 0);
#undef PK
}

struct Tensors { const bf16_t *Q, *KP, *VP; const float *CK, *CV, *NK, *NV; bf16_t* MIX; const float *rel_bias, *g_subln; float lam; };
template <int TYPE> struct Stg;
template <> struct Stg<0> { bf16x8 v0, v1, k0, k1;
    __device__ __forceinline__ void load(const bf16_t* kp, const bf16_t* vp) { v0 = *(const bf16x8*)vp; v1 = *(const bf16x8*)(vp + 32 * 1024); k0 = *(const bf16x8*)kp; k1 = *(const bf16x8*)(kp + 32 * 1024); }
    __device__ __forceinline__ bf16x8 V0() const { return v0; } __device__ __forceinline__ bf16x8 V1() const { return v1; } __device__ __forceinline__ bf16x8 K0() const { return k0; } __device__ __forceinline__ bf16x8 K1() const { return k1; } };
template <> struct Stg<1> { f32x4 v0[2], v1[2], k0[2], k1[2];
    __device__ __forceinline__ void load(const float* kp, const float* vp) { v0[0] = *(const f32x4*)vp; v0[1] = *(const f32x4*)(vp + 4); v1[0] = *(const f32x4*)(vp + 32 * 1024); v1[1] = *(const f32x4*)(vp + 32 * 1024 + 4);
        k0[0] = *(const f32x4*)kp; k0[1] = *(const f32x4*)(kp + 4); k1[0] = *(const f32x4*)(kp + 32 * 1024); k1[1] = *(const f32x4*)(kp + 32 * 1024 + 4); }
    __device__ __forceinline__ static bf16x8 cv(const f32x4 a, const f32x4 b) { u32x4 w; w.x = cvt_pk_bf16(a[0], a[1]); w.y = cvt_pk_bf16(a[2], a[3]); w.z = cvt_pk_bf16(b[0], b[1]); w.w = cvt_pk_bf16(b[2], b[3]); return __builtin_bit_cast(bf16x8, w); }
    __device__ __forceinline__ bf16x8 V0() const { return cv(v0[0], v0[1]); } __device__ __forceinline__ bf16x8 V1() const { return cv(v1[0], v1[1]); } __device__ __forceinline__ bf16x8 K0() const { return cv(k0[0], k0[1]); } __device__ __forceinline__ bf16x8 K1() const { return cv(k1[0], k1[1]); } };

template <int TYPE>
__device__ __forceinline__ void attn_unit(char* lds, int tid, const Tensors& T, int b, int h, int qb) {
    asm volatile("" : "+v"(tid));
    const int lane = tid & 63, r32 = lane & 31, hi = lane >> 5;
    const int wid = __builtin_amdgcn_readfirstlane(tid >> 6);
    const int rg = TYPE == 0 ? (wid & 3) : (wid & 1), mp = TYPE == 0 ? (wid >> 2) : ((wid >> 1) & 1), cs = TYPE == 0 ? 0 : (wid >> 2);
    constexpr int ND0 = TYPE == 0 ? 4 : 2;
    const long qrow0 = TYPE == 0 ? (long)b * SEQ + qb * 128 : (long)ROW_S0 + b * DSEQ;
    const bf16_t* Kh = T.KP + (size_t)b * LP * 1024 + h * 128;
    const bf16_t* Vh = T.VP + (size_t)b * LP * 1024 + h * 128;
    const float* Kc = T.CK + (size_t)b * LC * 1024 + h * 128; const float* Vc = T.CV + (size_t)b * LC * 1024 + h * 128;
    const float* Kn = T.NK + (size_t)b * DSEQ * 1024 + h * 128; const float* Vn = T.NV + (size_t)b * DSEQ * 1024 + h * 128;
    const int NT = TYPE == 0 ? 2 * qb + 3 : 34;
    const int qpos0 = TYPE == 0 ? qb * 128 : PAST;
    const int tmax = TYPE == 0 ? 2 * qb + (rg >> 1) + 1 : NT - 1;
    char* V_lds = lds + OFF_V; char* K_lds = lds + OFF_K; float* lut = (float*)(lds + OFF_LUT); float* wsf = (float*)(lds + OFF_WS) + wid * 64;
    if (tid < 256) { const int rel = tid - 128, n = rel < 0 ? -rel : rel;
        int bk = n < 8 ? n : n < 12 ? 8 : n < 16 ? 9 : n < 23 ? 10 : n < 32 ? 11 : n < 46 ? 12 : n < 64 ? 13 : n < 91 ? 14 : 15; if (rel > 0) bk += 16;
        lut[tid] = T.rel_bias[bk * NH + h] * LOG2E; }
    bf16x8 qr[4];
    { const bf16_t* Qw = T.Q + (size_t)(qrow0 + rg * 32 + r32) * 1024 + h * 128 + mp * 64 + hi * 8;
#pragma unroll
      for (int d0 = 0; d0 < 4; ++d0) qr[d0] = *(const bf16x8*)(Qw + d0 * 16); }
    const int qpos = qpos0 + rg * 32 + r32;
    const int sr = tid >> 4, sc = (tid & 15) * 8, vst0 = v_st(sr, sc), vst1 = v_st(32 + sr, sc);
    const int vb0 = (int)(uintptr_t)V_lds + v_rd_base(lane);
    Stg<TYPE> st;
#define KROW0(t) ((t) == 0 ? 0 : 16 + 64 * ((t) - 1))
#define SLOAD(t) do { const size_t ro_ = (size_t)(KROW0(t) + sr) * 1024 + sc; \
        if constexpr (TYPE == 0) st.load(Kh + ro_, Vh + ro_); \
        else { if ((t) < NT - 1) st.load(Kc + ro_, Vc + ro_); else st.load(Kn + (size_t)sr * 1024 + sc, Vn + (size_t)sr * 1024 + sc); } } while (0)
#define SWRITE(bf) do { *(bf16x8*)(V_lds + (bf) * SHM_V + vst0) = st.V0(); *(bf16x8*)(V_lds + (bf) * SHM_V + vst1) = st.V1(); \
        *(bf16x8*)(K_lds + (bf) * SHM_K + KSWZ(sr, sc * 2)) = st.K0(); *(bf16x8*)(K_lds + (bf) * SHM_K + KSWZ(32 + sr, sc * 2)) = st.K1(); } while (0)
    float m_reg = NEG, l_reg = 0.f; f32x16 o[ND0];
#pragma unroll
    for (int d = 0; d < ND0; ++d) o[d] = f32x16{};
    SLOAD(0); SWRITE(0); SLOAD(1);
    __syncthreads();
    for (int t = 0; t < NT; ++t) {
        const int buf = t & 1;
        if (t + 1 < NT) { SWRITE(buf ^ 1); if (t + 2 < NT) SLOAD(t + 2); }
        if (t <= tmax) {
            const int kpos0 = t == 0 ? -NMETA : 64 * (t - 1);
            f32x16 p0, p1;
            const bool far = (t != 0) && (kpos0 + 63 - (qpos0 + rg * 32) <= -128);
            if (far) { const float cbv = lut[0];
#pragma unroll
                for (int r = 0; r < 16; ++r) { p0[r] = cbv; p1[r] = cbv; } }
            else {
#pragma unroll
                for (int r = 0; r < 16; ++r) { const int kk = crow(r, hi); int i0 = kpos0 + kk - qpos + 128; const int i1 = min(max(i0 + 32, 0), 255); i0 = min(max(i0, 0), 255);
                    p0[r] = lut[i0]; p1[r] = lut[i1];
                    if (t == 0) { p0[r] = kk < NMETA ? p0[r] : NEG; p1[r] = NEG; } }
            }
            const char* Kb = K_lds + buf * SHM_K;
#pragma unroll
            for (int d0 = 0; d0 < 4; ++d0) { const int cbyte = (mp * 64 + d0 * 16 + hi * 8) * 2;
                const bf16x8 b0 = *(const bf16x8*)(Kb + KSWZ(r32, cbyte));
                p0 = __builtin_amdgcn_mfma_f32_32x32x16_bf16(b0, qr[d0], p0, 0, 0, 0);
                if (t != 0) { const bf16x8 b1 = *(const bf16x8*)(Kb + KSWZ(32 + r32, cbyte)); p1 = __builtin_amdgcn_mfma_f32_32x32x16_bf16(b1, qr[d0], p1, 0, 0, 0); } }
            float pmax = p0[0];
#pragma unroll
            for (int r = 1; r < 16; ++r) pmax = fmaxf(pmax, p0[r]);
#pragma unroll
            for (int r = 0; r < 16; ++r) pmax = fmaxf(pmax, p1[r]);
            { auto rr = __builtin_amdgcn_permlane32_swap(__float_as_uint(pmax), __float_as_uint(pmax), false, false); pmax = fmaxf(__uint_as_float(rr[0]), __uint_as_float(rr[1])); }
            float alpha = 1.f;
            if (!__all(pmax - m_reg <= THR2)) { const float mn = fmaxf(m_reg, pmax); alpha = __builtin_amdgcn_exp2f(m_reg - mn); m_reg = mn; }
            float ps = 0.f;
#pragma unroll
            for (int r = 0; r < 16; ++r) { p0[r] = __builtin_amdgcn_exp2f(p0[r] - m_reg); p1[r] = __builtin_amdgcn_exp2f(p1[r] - m_reg); ps += p0[r] + p1[r]; }
            { auto rr = __builtin_amdgcn_permlane32_swap(__float_as_uint(ps), __float_as_uint(ps), false, false); ps = __uint_as_float(rr[0]) + __uint_as_float(rr[1]); }
            l_reg = l_reg * alpha + ps;
            if (__any(alpha < 1.f)) { if (hi == 0) wsf[r32] = alpha; asm volatile("s_waitcnt lgkmcnt(0)" ::: "memory");
#pragma unroll
                for (int r = 0; r < 16; ++r) { const float a = wsf[crow(r, hi)];
#pragma unroll
                    for (int d = 0; d < ND0; ++d) o[d][r] *= a; }
                asm volatile("s_waitcnt lgkmcnt(0)" ::: "memory"); }
            bf16x8 pa0, pa1, pa2, pa3;
#define PK4(P, BASE, OUT) do { unsigned a0 = cvt_pk_bf16(P[BASE + 0], P[BASE + 1]), a1 = cvt_pk_bf16(P[BASE + 2], P[BASE + 3]); \
        unsigned b0_ = cvt_pk_bf16(P[BASE + 4], P[BASE + 5]), b1_ = cvt_pk_bf16(P[BASE + 6], P[BASE + 7]); \
        auto r0 = __builtin_amdgcn_permlane32_swap(a0, b0_, false, false); auto r1 = __builtin_amdgcn_permlane32_swap(a1, b1_, false, false); \
        u32x4 w = {r0[0], r1[0], r0[1], r1[1]}; OUT = *reinterpret_cast<bf16x8*>(&w); } while (0)
            PK4(p0, 0, pa0); PK4(p0, 8, pa1); PK4(p1, 0, pa2); PK4(p1, 8, pa3);
#undef PK4
            SBAR();
            const int vb = vb0 + buf * SHM_V;
            if (TYPE == 0) { pv_one<0>(o[0], vb, pa0, pa1, pa2, pa3); pv_one<1>(o[1], vb, pa0, pa1, pa2, pa3); pv_one<2>(o[ND0 - 2], vb, pa0, pa1, pa2, pa3); pv_one<3>(o[ND0 - 1], vb, pa0, pa1, pa2, pa3); }
            else if (cs == 0) { pv_one<0>(o[0], vb, pa0, pa1, pa2, pa3); pv_one<1>(o[1], vb, pa0, pa1, pa2, pa3); }
            else { pv_one<2>(o[0], vb, pa0, pa1, pa2, pa3); pv_one<3>(o[1], vb, pa0, pa1, pa2, pa3); }
        }
        __syncthreads();
    }
    if (hi == 0) wsf[r32] = l_reg; asm volatile("s_waitcnt lgkmcnt(0)" ::: "memory");
    float* Tt = (float*)lds;
    const float sgn = mp == 0 ? 1.f : -T.lam;
    float rli[16];
#pragma unroll
    for (int r = 0; r < 16; ++r) rli[r] = sgn * __builtin_amdgcn_rcpf(wsf[crow(r, hi)]);
    if (mp == 0) {
#pragma unroll
        for (int r = 0; r < 16; ++r)
#pragma unroll
            for (int d = 0; d < ND0; ++d) Tt[(rg * 32 + crow(r, hi)) * 128 + (cs * 2 + d) * 32 + r32] = o[d][r] * rli[r];
    }
    __syncthreads();
    if (mp == 1) {
#pragma unroll
        for (int r = 0; r < 16; ++r)
#pragma unroll
            for (int d = 0; d < ND0; ++d) Tt[(rg * 32 + crow(r, hi)) * 128 + (cs * 2 + d) * 32 + r32] += o[d][r] * rli[r];
    }
    __syncthreads();
    constexpr int RPW = (TYPE == 0 ? 128 : 64) / 8;
    const f32x2 gs = *(const f32x2*)(T.g_subln + lane * 2);
#pragma unroll 4
    for (int i = 0; i < RPW; ++i) { const int row = wid * RPW + i; const f32x2 v = *(const f32x2*)(Tt + row * 128 + lane * 2);
        const float ss = wave_sum(v.x * v.x + v.y * v.y); const float rstd = 0.8f / sqrtf(ss * (1.0f / 128.0f) + SUBLN_EPS);
        *(unsigned*)(T.MIX + (size_t)(qrow0 + row) * 2048 + 1024 + h * 128 + lane * 2) = cvt_pk_bf16(v.x * rstd * gs.x, v.y * rstd * gs.y); }
    __syncthreads();
#undef KROW0
#undef SLOAD
#undef SWRITE
}
#undef KSWZ
#undef SBAR
}

__device__ __forceinline__ void transpose_item(const float* W, int K, int N, bf16_t* WT, int k0, int n0, int dst_row0, LAS float* scr, int lane) {
    f32x4 v[16];
    const float* src = W + (size_t)(k0 + (lane >> 4)) * N + n0 + 4 * (lane & 15);
#pragma unroll
    for (int i = 0; i < 16; ++i) v[i] = *(const f32x4*)(src + (size_t)(4 * i) * N);
    LAS float* d = scr + (lane >> 4) * 65 + 4 * (lane & 15);
#pragma unroll
    for (int i = 0; i < 16; ++i) { d[4 * i * 65 + 0] = v[i][0]; d[4 * i * 65 + 1] = v[i][1]; d[4 * i * 65 + 2] = v[i][2]; d[4 * i * 65 + 3] = v[i][3]; }
    asm volatile("s_waitcnt lgkmcnt(0)" ::: "memory");
    const int c = lane & 7;
#pragma unroll
    for (int j = 0; j < 8; ++j) { const int n = (lane >> 3) + 8 * j; const LAS float* s = scr + (8 * c) * 65 + n;
        u32x4 o; o.x = cvt_pk_bf16(s[0 * 65], s[1 * 65]); o.y = cvt_pk_bf16(s[2 * 65], s[3 * 65]); o.z = cvt_pk_bf16(s[4 * 65], s[5 * 65]); o.w = cvt_pk_bf16(s[6 * 65], s[7 * 65]);
        *(u32x4*)(WT + (size_t)(dst_row0 + n) * K + k0 + 8 * c) = o; }
    asm volatile("s_waitcnt lgkmcnt(0)" ::: "memory");
}
__device__ __forceinline__ void rms_row_to_bf16(const float* xrow, const float* g, bf16_t* orow, int lane) {
    f32x4 v[8]; float s = 0.f;
#pragma unroll
    for (int j = 0; j < 8; ++j) { v[j] = *((const f32x4*)xrow + lane + 64 * j); s += (v[j][0] * v[j][0] + v[j][1] * v[j][1]) + (v[j][2] * v[j][2] + v[j][3] * v[j][3]); }
    const float rstd = 1.0f / sqrtf(wave_sum(s) * (1.0f / DM) + EPS);
#pragma unroll
    for (int j = 0; j < 8; ++j) { const f32x4 gg = *((const f32x4*)g + lane + 64 * j); const f32x4 y = v[j] * rstd * gg; u32x2 w; w.x = cvt_pk_bf16(y[0], y[1]); w.y = cvt_pk_bf16(y[2], y[3]);
        *((u32x2*)orow + lane + 64 * j) = w; }
}

struct Args {
    const float *x_prompt, *x_sample, *cache_k, *cache_v, *state_pool, *meta, *g_mix, *w_in, *w_pool, *pool_scale, *lq1, *lk1, *lq2, *lk2, *g_subln, *w_out, *g_ffn, *w_gate, *w_up, *w_down, *rel_bias, *g_final;
    float* out; unsigned char* ws;
};
constexpr int LDS_BYTES = 147456, LDS_MISC = 147456 - 64;

__global__ void __launch_bounds__(512, 2) fwd_kernel(Args a) {
    extern __shared__ __attribute__((aligned(16))) unsigned char lds[];
    cg::grid_group grid = cg::this_grid();
    if (threadIdx.x < 16) ((LAS unsigned*)((LAS unsigned char*)lds + LDS_MISC))[threadIdx.x] = 0u;
    __syncthreads();
    if (threadIdx.x == 0) (void)xb_add((unsigned*)(a.ws + WS_CTL) + CW_BAR + XB_XCNT(xb_xcc_id()), 1u);
#define GRID_BAR() do { unsigned char* w_ = a.ws; asm volatile("" : "+s"(w_)); \
        xcd_barrier((unsigned*)(w_ + WS_CTL) + CW_BAR, (volatile LAS unsigned*)((LAS unsigned char*)lds + LDS_MISC), __builtin_amdgcn_mbcnt_hi(~0u, __builtin_amdgcn_mbcnt_lo(~0u, 0u)) == 0u && wave0_ == 0); } while (0)
    int wave0_ = __builtin_amdgcn_readfirstlane(threadIdx.x >> 6);
#define PH_BEGIN \
    int wave = wave0_; asm volatile("" : "+s"(wave)); \
    int tid = wave * 64 + (int)__builtin_amdgcn_mbcnt_hi(~0u, __builtin_amdgcn_mbcnt_lo(~0u, 0u)); asm volatile("" : "+v"(tid)); \
    const int lane = tid & 63; \
    int G = gridDim.x, bx = blockIdx.x; asm volatile("" : "+s"(G), "+s"(bx)); \
    const int vcu = (G % 8 == 0) ? (bx % 8) * (G / 8) + bx / 8 : bx; \
    unsigned char* ws = a.ws; asm volatile("" : "+s"(ws)); \
    const int gw = vcu * 8 + wave, NGW = G * 8, gt = bx * 512 + tid, NGT = G * 512; \
    (void)lane; (void)gw; (void)NGW; (void)gt; (void)NGT; (void)vcu;
#define WSP(T, off) ((T*)(ws + (off)))
#define SS1 ((float*)(ws + WS_CTL) + CW_SS1)
#define SS2 ((float*)(ws + WS_CTL) + CW_SS2)

    {
        PH_BEGIN
        LAS float* scr = (LAS float*)((LAS unsigned char*)lds + wave * 16640);
        constexpr int I_IN = (DM / 64) * (INW / 64), I_OUT = (DM / 64) * (DM / 64), I_G = (DM / 64) * (DFF / 64), I_D = (DFF / 64) * (DM / 64), I_P = 4 * 16;
        constexpr int NIT = I_IN + I_OUT + 2 * I_G + I_D + I_P;
        for (int it = gw; it < NIT; it += NGW) {
            int r = it;
            if (r < I_IN) { const int nb = INW / 64, kb = r / nb, n0 = (r % nb) * 64; transpose_item(a.w_in, DM, INW, WSP(bf16_t, WS_WINT), kb * 64, n0, n0, scr, lane); continue; } r -= I_IN;
            if (r < I_OUT) { const int nb = DM / 64, kb = r / nb, n0 = (r % nb) * 64; transpose_item(a.w_out, DM, DM, WSP(bf16_t, WS_WOUTT), kb * 64, n0, n0, scr, lane); continue; } r -= I_OUT;
            if (r < I_G) { const int nb = DFF / 64, kb = r / nb, n0 = (r % nb) * 64; transpose_item(a.w_gate, DM, DFF, WSP(bf16_t, WS_WGUT), kb * 64, n0, (n0 >> 7) * 256 + (n0 & 127), scr, lane); continue; } r -= I_G;
            if (r < I_G) { const int nb = DFF / 64, kb = r / nb, n0 = (r % nb) * 64; transpose_item(a.w_up, DM, DFF, WSP(bf16_t, WS_WGUT), kb * 64, n0, (n0 >> 7) * 256 + 128 + (n0 & 127), scr, lane); continue; } r -= I_G;
            if (r < I_D) { const int nb = DM / 64, kb = r / nb, n0 = (r % nb) * 64; transpose_item(a.w_down, DFF, DM, WSP(bf16_t, WS_WDT), kb * 64, n0, n0, scr, lane); continue; } r -= I_D;
            { const int g = r / 16, q = r % 16, kb = q / 4, n0 = (q % 4) * 64; transpose_item(a.w_pool + (size_t)g * 65536, 256, 256, WSP(bf16_t, WS_WPT) + (size_t)g * 65536, kb * 64, n0, n0, scr, lane); }
        }
        for (int m = gw; m < MPAD; m += NGW) {
            bf16_t* orow = WSP(bf16_t, WS_XN) + (size_t)m * DM;
            if (m < ROW_S0) rms_row_to_bf16(a.x_prompt + (size_t)m * DM, a.g_mix, orow, lane);
            else if (m < ROW_M0) rms_row_to_bf16(a.x_sample + (size_t)(m - ROW_S0) * DM, a.g_mix, orow, lane);
            else if (m < ROW_M0 + NMETA) rms_row_to_bf16(a.meta + (size_t)(m - ROW_M0) * DM, a.g_mix, orow, lane);
            else { for (int j = 0; j < 4; ++j) *((u32x4*)orow + lane + 64 * j) = (u32x4){0u, 0u, 0u, 0u}; }
        }
        { const int n8 = DB * 15 * 128;
          for (int i = gt; i < n8; i += NGT) { const int row = i >> 7, c8 = i & 127, b = row / 15, j = row % 15; const float* src = a.state_pool + (size_t)i * 8;
              *(u32x4*)(WSP(bf16_t, WS_US) + ((size_t)b * 79 + j) * 1024 + c8 * 8) = pack8(*(const f32x4*)src, *(const f32x4*)(src + 4)); } }
    }
    grid.sync();

    {
        PH_BEGIN
        pg8::Gemm g{WSP(bf16_t, WS_XN), WSP(bf16_t, WS_WINT), DM, DM, DM, 0}; pg8::StaticOrder S; S.init(MPAD / 256, INW / 256, G, bx);
        EpiInProj E{WSP(bf16_t, WS_Q), WSP(bf16_t, WS_KP), WSP(bf16_t, WS_VP), WSP(bf16_t, WS_UP), WSP(bf16_t, WS_US), a.out};
        pg8::gemm_phase<EpiInProj>((LAS unsigned char*)lds, tid, g, S, E);
    }
    GRID_BAR();

    {
        PH_BEGIN
        for (int i = gt; i < MROWS * 128; i += NGT) {
            const int r = i >> 7, c8 = i & 127, gidx = c8 >> 5, w = 2 << gidx;
            const bf16_t* up = r < ROW_S0 ? WSP(bf16_t, WS_UP) + ((size_t)(r >> 11) * LP + 16 + (r & 2047)) * 1024 + c8 * 8 : WSP(bf16_t, WS_US) + ((size_t)((r - ROW_S0) >> 6) * 79 + 15 + ((r - ROW_S0) & 63)) * 1024 + c8 * 8;
            float s[8], u0[8];
            { const bf16x8 v = *(const bf16x8*)up;
#pragma unroll
              for (int e = 0; e < 8; ++e) { u0[e] = bf2f((unsigned short)v[e]); s[e] = u0[e]; } }
            for (int j = 1; j < w; ++j) { const bf16x8 v = *(const bf16x8*)(up - (size_t)j * 1024);
#pragma unroll
                for (int e = 0; e < 8; ++e) s[e] += bf2f((unsigned short)v[e]); }
            const float inv = 1.0f / (float)w; f32x4 p0, p1;
#pragma unroll
            for (int e = 0; e < 4; ++e) { p0[e] = s[e] * inv - u0[e]; p1[e] = s[4 + e] * inv - u0[4 + e]; }
            *(u32x4*)(WSP(bf16_t, WS_P) + (size_t)r * 1024 + c8 * 8) = pack8(p0, p1);
        }
    }
    GRID_BAR();

    {
        PH_BEGIN
        pg8::Gemm g{WSP(bf16_t, WS_P), WSP(bf16_t, WS_WPT), 1024, 256, 256, 256}; pg8::StaticOrder S; S.init(MROWS / 256, 4, G, bx);
        EpiPool E{WSP(bf16_t, WS_MIX), a.pool_scale};
        pg8::gemm_phase<EpiPool>((LAS unsigned char*)lds, tid, g, S, E);
    }
    {
        PH_BEGIN
        const float d1 = wave_sum(a.lq1[lane] * a.lk1[lane]), d2 = wave_sum(a.lq2[lane] * a.lk2[lane]);
        att::Tensors T{WSP(bf16_t, WS_Q), WSP(bf16_t, WS_KP), WSP(bf16_t, WS_VP), a.cache_k, a.cache_v, a.out + O_KS, a.out + O_VS, WSP(bf16_t, WS_MIX), a.rel_bias, a.g_subln, __expf(d1) - __expf(d2) + 0.2f};
        unsigned* qctr = (unsigned*)(ws + WS_CTL) + CW_QATT;
        volatile LAS int* slot = (volatile LAS int*)((LAS unsigned char*)lds + LDS_MISC + 16);
        for (;;) {
            if (tid == 0) *slot = (int)atomicAdd(qctr, 1u);
            __syncthreads();
            const int j = __builtin_amdgcn_readfirstlane(*slot);
            __syncthreads();
            if (j >= 128 + 512) break;
            if (j < 128) att::attn_unit<1>((char*)lds, tid, T, j >> 3, j & 7, 0);
            else { const int k = j - 128, bh = k & 31; att::attn_unit<0>((char*)lds, tid, T, bh >> 3, bh & 7, 15 - (k >> 5)); }
        }
    }
    GRID_BAR();

    {
        PH_BEGIN
        pg8::Gemm g{WSP(bf16_t, WS_MIX), WSP(bf16_t, WS_WOUTT), DM, DM, DM, 0}; pg8::StaticOrder S; S.init(MROWS / 256, DM / 256, G, bx);
        EpiOutProj E{a.x_prompt, a.x_sample, a.g_ffn, WSP(float, WS_H1), WSP(bf16_t, WS_XN), SS1};
        pg8::gemm_phase<EpiOutProj>((LAS unsigned char*)lds, tid, g, S, E);
    }
    GRID_BAR();

    {
        PH_BEGIN
        pg8::Gemm g{WSP(bf16_t, WS_XN), WSP(bf16_t, WS_WGUT), DM, DM, DM, 0}; pg8::StaticOrder S; S.init(MROWS / 256, 2 * DFF / 256, G, bx);
        EpiFFN1 E{WSP(bf16_t, WS_HMID), SS1};
        pg8::gemm_phase<EpiFFN1>((LAS unsigned char*)lds, tid, g, S, E);
    }
    GRID_BAR();

    {
        PH_BEGIN
        pg8::Gemm g{WSP(bf16_t, WS_HMID), WSP(bf16_t, WS_WDT), DFF, DFF, DFF, 0}; pg8::StaticOrder S; S.init(MROWS / 256, DM / 256, G, bx);
        EpiDown E{WSP(float, WS_H1), a.out + O_Y, SS2};
        pg8::gemm_phase<EpiDown>((LAS unsigned char*)lds, tid, g, S, E);
    }
    GRID_BAR();

    {
        PH_BEGIN
        for (int m = gw; m < MROWS; m += NGW) {
            float* yr = a.out + O_Y + (size_t)m * DM; const float rstd = 1.0f / sqrtf(SS2[m] * (1.0f / DM) + EPS);
#pragma unroll
            for (int j = 0; j < 8; ++j) { const f32x4 gg = *((const f32x4*)a.g_final + lane + 64 * j); f32x4* p = (f32x4*)yr + lane + 64 * j; *p = *p * rstd * gg; }
        }
    }
}

extern "C" void kernel_launch(void* const* d_in, const int* in_sizes, int n_in, void* d_out, int out_size, void* d_ws, size_t ws_size, hipStream_t stream) {
    static int grid = 0;
    if (grid == 0) {
        if (n_in != 22 || out_size != (int)O_END || ws_size < WS_END) { fprintf(stderr, "kernel_launch: unexpected shapes: n_in %d out %d ws %zu\n", n_in, out_size, ws_size); grid = -1; return; }
        int dev = 0, cus = 0, per_cu = 0;
        hipGetDevice(&dev); hipDeviceGetAttribute(&cus, hipDeviceAttributeMultiprocessorCount, dev);
        if (hipFuncSetAttribute((const void*)fwd_kernel, hipFuncAttributeMaxDynamicSharedMemorySize, LDS_BYTES) != hipSuccess) { fprintf(stderr, "kernel_launch: hipFuncSetAttribute failed\n"); grid = -1; return; }
        hipOccupancyMaxActiveBlocksPerMultiprocessor(&per_cu, (const void*)fwd_kernel, 512, LDS_BYTES);
        if (per_cu < 1) { fprintf(stderr, "kernel_launch: occupancy query says %d blocks per CU\n", per_cu); grid = -1; return; }
        grid = cus;
    }
    if (grid < 0) return;
    hipMemsetAsync((char*)d_ws + WS_CTL, 0, CTL_BYTES, stream);
    Args a{};
    const float** p = (const float**)&a;
    for (int i = 0; i < 22; ++i) p[i] = (const float*)d_in[i];
    a.out = (float*)d_out; a.ws = (unsigned char*)d_ws;
    void* args[] = {&a};
    hipError_t e = hipLaunchCooperativeKernel((const void*)fwd_kernel, dim3(grid), dim3(512), args, LDS_BYTES, stream);
    if (e != hipSuccess) fprintf(stderr, "cooperative launch failed: %s (grid %d)\n", hipGetErrorString(e), grid);
}
```
